# Optimizing an MI355X kernel written in HIP

```python
import math
import jax, jax.numpy as jnp
from jax import lax
import numpy as np

D_MODEL = 2048
BATCH = 1
SEQ = 16384
DEPTH = 1

GRID_W = 64
ROPE_THETA = 10000.0
N_Q_HEADS = 8
N_KV_HEADS = 2
HEAD_DIM = 128
GQA_GROUP = N_Q_HEADS // N_KV_HEADS
BLOCK_Q = 128
ATTN_WIDTH = N_Q_HEADS * HEAD_DIM
KV_WIDTH = N_KV_HEADS * HEAD_DIM
SGU_GROUPS = 8
SGU_GROUP_DIM = 128
SGU_WIDTH = SGU_GROUPS * SGU_GROUP_DIM
SGU_CHUNK = 128
N_BRANCHES = 2
IN_WIDTH = ATTN_WIDTH + 2 * KV_WIDTH + 2 * SGU_WIDTH + N_BRANCHES * D_MODEL
SPLITS = (ATTN_WIDTH,
          ATTN_WIDTH + KV_WIDTH,
          ATTN_WIDTH + 2 * KV_WIDTH,
          ATTN_WIDTH + 2 * KV_WIDTH + SGU_WIDTH,
          ATTN_WIDTH + 2 * KV_WIDTH + 2 * SGU_WIDTH)
PEER_HEADS = 8
PEER_N_KEYS = 128
PEER_N_EXPERTS = PEER_N_KEYS * PEER_N_KEYS
PEER_QUERY_DIM = 256
PEER_HALF = PEER_QUERY_DIM // 2
PEER_TOPK = 16
PEER_BLOCK = 128
EPS = 1e-6

kernel_name = "hybrid_gqa_sgu_peer_block"


def rmsnorm(x, g):
    xf = x.astype(jnp.float32)
    y = xf * lax.rsqrt(jnp.mean(xf * xf, axis=-1, keepdims=True) + EPS)
    return (y * g.astype(jnp.float32)).astype(x.dtype)


def axial_rope_tables(seq_len):
    rows = seq_len // GRID_W
    row = jnp.repeat(jnp.arange(rows, dtype=jnp.float32), GRID_W)
    col = jnp.tile(jnp.arange(GRID_W, dtype=jnp.float32), rows)
    n_pairs = HEAD_DIM // 4
    inv_freq = ROPE_THETA ** (-jnp.arange(n_pairs, dtype=jnp.float32) / n_pairs)
    ang = jnp.concatenate([row[:, None] * inv_freq, col[:, None] * inv_freq], axis=-1)
    return jnp.cos(ang), jnp.sin(ang)


def apply_rope(x, cos, sin):
    B, S, H, D = x.shape
    xp = x.astype(jnp.float32).reshape(B, S, H, D // 2, 2)
    x1, x2 = xp[..., 0], xp[..., 1]
    c = cos[None, :, None, :]
    s = sin[None, :, None, :]
    out = jnp.stack([x1 * c - x2 * s, x1 * s + x2 * c], axis=-1)
    return out.reshape(B, S, H, D).astype(x.dtype)


def block_attention(q, k, v):
    B, S, _, hd = q.shape
    n_blk = S // BLOCK_Q
    scale = 1.0 / math.sqrt(HEAD_DIM)
    qb = jnp.moveaxis(q.reshape(B, n_blk, BLOCK_Q, N_KV_HEADS, GQA_GROUP, hd), 1, 0)

    def one_block(q_blk):
        s = jnp.einsum('bqkgd,bskd->bkgqs', q_blk, k).astype(jnp.float32) * scale
        p = jax.nn.softmax(s, axis=-1).astype(v.dtype)
        return jnp.einsum('bkgqs,bskd->bqkgd', p, v)

    o = lax.map(one_block, qb)
    return jnp.moveaxis(o, 0, 1).reshape(B, S, N_Q_HEADS * hd)


def spatial_gating(u, v, g_v, w_s, b_s):
    B, S, _ = u.shape
    n_chunk = S // SGU_CHUNK
    vn = rmsnorm(v, g_v).reshape(B, n_chunk, SGU_CHUNK, SGU_GROUPS, SGU_GROUP_DIM)
    mixed = jnp.einsum('gpq,bcqgd->bcpgd', w_s, vn) + b_s.T[None, None, :, :, None]
    return u * mixed.reshape(B, S, SGU_WIDTH)


def peer_ffn(xn, w_q, sub_k1, sub_k2, u_tab, v_tab):
    B, S, D = xn.shape
    q = (xn @ w_q).reshape(B, S, PEER_HEADS, PEER_QUERY_DIM)
    s1 = jnp.einsum('bshd,hnd->bshn', q[..., :PEER_HALF], sub_k1).astype(jnp.float32)
    s2 = jnp.einsum('bshd,hnd->bshn', q[..., PEER_HALF:], sub_k2).astype(jnp.float32)
    v1, i1 = lax.top_k(s1, PEER_TOPK)
    v2, i2 = lax.top_k(s2, PEER_TOPK)
    cand = (v1[..., :, None] + v2[..., None, :]).reshape(B, S, PEER_HEADS, PEER_TOPK * PEER_TOPK)
    cv, ci = lax.top_k(cand, PEER_TOPK)
    e1 = jnp.take_along_axis(i1, ci // PEER_TOPK, axis=-1)
    e2 = jnp.take_along_axis(i2, ci % PEER_TOPK, axis=-1)
    experts = (e1 * PEER_N_KEYS + e2).astype(jnp.int32)
    gates = jax.nn.softmax(cv, axis=-1).astype(xn.dtype)
    T = B * S
    n_blk = T // PEER_BLOCK
    hk = PEER_HEADS * PEER_TOPK
    xt = xn.reshape(n_blk, PEER_BLOCK, D)
    et = experts.reshape(n_blk, PEER_BLOCK, hk)
    gt = gates.reshape(n_blk, PEER_BLOCK, hk)

    def one_block(args):
        xb, eb, gb = args
        ue = jnp.take(u_tab, eb, axis=0)
        a = jax.nn.gelu(jnp.einsum('tkd,td->tk', ue, xb)) * gb
        ve = jnp.take(v_tab, eb, axis=0)
        return jnp.einsum('tk,tkd->td', a, ve)

    return lax.map(one_block, (xt, et, gt)).reshape(B, S, D)


def setup_inputs(seed: int = 0) -> dict:
    key = jax.random.key(seed)
    ks = jax.random.split(key, 20)
    f32 = jnp.float32
    nrm = lambda k, shape, scale: jax.random.normal(k, shape, f32) * scale
    L = DEPTH
    return {
        "x": nrm(ks[0], (BATCH, SEQ, D_MODEL), 1.0),
        "norm_mix": 1.0 + nrm(ks[1], (L, D_MODEL), 0.01),
        "w_in": nrm(ks[2], (L, D_MODEL, IN_WIDTH), D_MODEL ** -0.5),
        "b_gate": nrm(ks[3], (L, N_BRANCHES * D_MODEL), 0.01),
        "q_norm": 1.0 + nrm(ks[4], (L, HEAD_DIM), 0.01),
        "k_norm": 1.0 + nrm(ks[5], (L, HEAD_DIM), 0.01),
        "sgu_norm": 1.0 + nrm(ks[6], (L, SGU_WIDTH), 0.01),
        "w_sgu": nrm(ks[7], (L, SGU_GROUPS, SGU_CHUNK, SGU_CHUNK), SGU_CHUNK ** -0.5),
        "b_sgu": 1.0 + nrm(ks[8], (L, SGU_GROUPS, SGU_CHUNK), 0.01),
        "w_attn_proj": nrm(ks[9], (L, ATTN_WIDTH, D_MODEL), ATTN_WIDTH ** -0.5),
        "w_sgu_proj": nrm(ks[10], (L, SGU_WIDTH, D_MODEL), SGU_WIDTH ** -0.5),
        "w_out": nrm(ks[11], (L, D_MODEL, D_MODEL), D_MODEL ** -0.5),
        "norm_ffn": 1.0 + nrm(ks[12], (L, D_MODEL), 0.01),
        "w_peer_q": nrm(ks[13], (L, D_MODEL, PEER_HEADS * PEER_QUERY_DIM), D_MODEL ** -0.5),
        "peer_k1": nrm(ks[14], (L, PEER_HEADS, PEER_N_KEYS, PEER_HALF), PEER_HALF ** -0.5),
        "peer_k2": nrm(ks[15], (L, PEER_HEADS, PEER_N_KEYS, PEER_HALF), PEER_HALF ** -0.5),
        "peer_u": nrm(ks[16], (L, PEER_N_EXPERTS, D_MODEL), D_MODEL ** -0.5),
        "peer_v": nrm(ks[17], (L, PEER_N_EXPERTS, D_MODEL), PEER_HEADS ** -0.5),
    }


def reference(x, norm_mix, w_in, b_gate, q_norm, k_norm, sgu_norm, w_sgu, b_sgu,
              w_attn_proj, w_sgu_proj, w_out, norm_ffn, w_peer_q, peer_k1, peer_k2,
              peer_u, peer_v):
    B, S, _ = x.shape
    cos, sin = axial_rope_tables(S)
    h = x
    for l in range(DEPTH):
        hn = rmsnorm(h, norm_mix[l])
        z = hn @ w_in[l]
        q, k, v, su, sv, g = jnp.split(z, SPLITS, axis=-1)
        q = apply_rope(rmsnorm(q.reshape(B, S, N_Q_HEADS, HEAD_DIM), q_norm[l]), cos, sin)
        k = apply_rope(rmsnorm(k.reshape(B, S, N_KV_HEADS, HEAD_DIM), k_norm[l]), cos, sin)
        v = v.reshape(B, S, N_KV_HEADS, HEAD_DIM)
        attn = block_attention(q, k, v)
        sgu = spatial_gating(jax.nn.gelu(su), jax.nn.gelu(sv), sgu_norm[l], w_sgu[l], b_sgu[l])
        gates = jax.nn.sigmoid((g + b_gate[l]).astype(jnp.float32)).astype(h.dtype)
        g_attn, g_sgu = jnp.split(gates, N_BRANCHES, axis=-1)
        merged = g_attn * (attn @ w_attn_proj[l]) + g_sgu * (sgu @ w_sgu_proj[l])
        h = h + merged @ w_out[l]
        h = h + peer_ffn(rmsnorm(h, norm_ffn[l]), w_peer_q[l], peer_k1[l], peer_k2[l],
                         peer_u[l], peer_v[l])
    return h
```

```cpp
#include <hip/hip_runtime.h>
#include <cstdio>
#include <cstdint>

#ifndef MK_N_LAUNCHES
#define MK_N_LAUNCHES 1
#endif

#ifndef PHASE_MASK
#define PHASE_MASK 0xff
#endif
#ifndef SELFCHECK
#define SELFCHECK 0
#endif
#ifndef SELFCHECK_BUG
#define SELFCHECK_BUG 0
#endif
#ifndef PROBE_SPLIT
#define PROBE_SPLIT -1
#endif
#define LAS __attribute__((address_space(3)))
typedef unsigned short bf16_t;
typedef short bf16x8 __attribute__((ext_vector_type(8)));
typedef short s16x4 __attribute__((ext_vector_type(4)));
typedef float f32x4 __attribute__((ext_vector_type(4)));
typedef float f32x2 __attribute__((ext_vector_type(2)));
typedef float f32x8 __attribute__((ext_vector_type(8)));
typedef float f32x16 __attribute__((ext_vector_type(16)));
typedef unsigned u32x4 __attribute__((ext_vector_type(4)));
typedef unsigned u32x2 __attribute__((ext_vector_type(2)));

constexpr int SEQ = 16384, DM = 2048, NIN = 7680, QW = 1024, KVW = 256, SGW = 1024, HD = 128;
constexpr int NPH = 8;
constexpr float EPS = 1e-6f;

constexpr size_t MiB = 1u << 20;
constexpr size_t WS_CTL = 0, CTL_ZERO_BYTES = 1 * MiB;
constexpr size_t WS_RSTD1 = 1 * MiB;
constexpr size_t WS_RSX = 1 * MiB + 64 * 1024;
constexpr size_t WS_SWG = 1 * MiB + 256 * 1024;
constexpr size_t WS_SU = 1 * MiB + 128 * 1024, WS_SV = 1 * MiB + 192 * 1024;
constexpr size_t WS_SSQV = 2 * MiB;
constexpr size_t WS_SSQ2 = 3 * MiB;
constexpr size_t WS_K1 = 5 * MiB, WS_K2 = WS_K1 + 256 * 1024, WS_WSGU = WS_K2 + 256 * 1024;
constexpr size_t WS_PCAT = 6 * MiB;
constexpr size_t WS_WOUT = 14 * MiB;
constexpr size_t WS_WPQ = 22 * MiB;
constexpr size_t WS_B = 30 * MiB;
constexpr size_t WS_C = 94 * MiB;
constexpr size_t WS_D = 124 * MiB;
constexpr size_t WS_E = 236 * MiB;
constexpr size_t WS_F = 300 * MiB;
constexpr size_t WS_X8 = WS_B, WS_WG8 = WS_C;
constexpr size_t WS_DBGK = 492 * MiB, WS_DBGS = 500 * MiB;
constexpr size_t WS_END = SELFCHECK ? 504 * MiB : 492 * MiB;
constexpr int QROWS_P1 = 3072;
constexpr size_t WS_Q = WS_D, WS_K = WS_D + 32 * MiB, WS_V = WS_D + 40 * MiB, WS_GU = WS_D + 48 * MiB, WS_GV = WS_D + 80 * MiB;
constexpr size_t WS_EIDX = WS_C, WS_GATE = WS_C + 8 * MiB, WS_USU = WS_C + 16 * MiB;
constexpr size_t WS_UT = 428 * MiB, WS_VT = 460 * MiB;
constexpr int CW_BAR = 4096, CW_CHK = 64;

constexpr int RING_BYTES = 131072;
constexpr int MISC_OFF = RING_BYTES;
constexpr int RS2_OFF = RING_BYTES + 256;
constexpr int LDS_BYTES = 147456;

__device__ __forceinline__ unsigned cvt_pk_bf16(float lo, float hi) { unsigned r; asm volatile("v_cvt_pk_bf16_f32 %0, %1, %2" : "=v"(r) : "v"(lo), "v"(hi)); return r; }
__device__ __forceinline__ float bf_lo(unsigned w) { return __uint_as_float(w << 16); }
__device__ __forceinline__ float bf_hi(unsigned w) { return __uint_as_float(w & 0xffff0000u); }
__device__ __forceinline__ float wave_sum(float v) {
#pragma unroll
    for (int o = 1; o < 64; o <<= 1) v += __shfl_xor(v, o);
    return v;
}
__device__ __forceinline__ float gelu_tanh(float x) {
    const float u = x * (0.7978845608028654f + 0.035677408136300125f * x * x);
    const float e = __builtin_amdgcn_exp2f(-2.885390081777927f * u);
    return x * __builtin_amdgcn_rcpf(1.0f + e);
}
#define TRANS_FENCE2(a, b) asm volatile("s_nop 0" : "+v"(a), "+v"(b))
__device__ __forceinline__ float sat8(float x) { return __builtin_amdgcn_fmed3f(x, -448.0f, 448.0f); }
__device__ __forceinline__ float sigmoidf_(float x) { return __builtin_amdgcn_rcpf(1.0f + __builtin_amdgcn_exp2f(-1.4426950408889634f * x)); }

#define XB_TMO      128
#define XB_XCNT(j)  (256  + 64 * (j))
#define XB_XSUB(j)  (1280 + 64 * (j))
#define XB_XGEN(j)  (2304 + 64 * (j))
#define XB_TOP      3328
#define XB_TOPGEN   3392
#define XCD_BAR_WORDS 3456
#define XB_SPIN_CAP (1u << 18)
__device__ __forceinline__ unsigned xb_ld(unsigned* p)              { return __hip_atomic_load(p, __ATOMIC_RELAXED, __HIP_MEMORY_SCOPE_AGENT); }
__device__ __forceinline__ unsigned xb_add(unsigned* p, unsigned v) { return __hip_atomic_fetch_add(p, v, __ATOMIC_RELAXED, __HIP_MEMORY_SCOPE_AGENT); }
__device__ __forceinline__ unsigned xb_xcc_id() { return (unsigned)__builtin_amdgcn_s_getreg((3 << 11) | 20) & 0xFu; }
#define XB_SPIN(cond, bar) do { unsigned _sp = 0; while (cond) { __builtin_amdgcn_s_sleep(1); \
    if ((++_sp & 255u) == 0u) { if (xb_ld(&(bar)[XB_TMO])) break; if (_sp > XB_SPIN_CAP) { atomicAdd(&(bar)[XB_TMO], 1u); break; } } } } while (0)
struct XcdBarrier { unsigned* bar; unsigned x; volatile LAS unsigned* st; };
__device__ __forceinline__ XcdBarrier xcd_barrier_post(unsigned* bar, volatile LAS unsigned* st) {
    XcdBarrier b; b.bar = bar; b.x = xb_xcc_id(); b.st = st;
    if (threadIdx.x == 0) (void)xb_add(&bar[XB_XCNT(b.x)], 1u);
    return b;
}
__device__ __forceinline__ void xcd_barrier_complete(unsigned* bar, unsigned x, unsigned& nloc, unsigned& nx) {
    const unsigned G = gridDim.x * gridDim.y * gridDim.z;
    unsigned sum, cnt, mine, sp = 0u;
    for (;;) {
        sum = 0u; cnt = 0u; mine = 0u;
#pragma unroll
        for (unsigned j = 0; j < 16; ++j) { const unsigned c = xb_ld(&bar[XB_XCNT(j)]); sum += c; cnt += (c > 0u) ? 1u : 0u; mine = (j == x) ? c : mine; }
        if (sum == G) break;
        __builtin_amdgcn_s_sleep(1);
        if ((++sp & 255u) == 0u) { if (xb_ld(&bar[XB_TMO])) break; if (sp > XB_SPIN_CAP) { atomicAdd(&bar[XB_TMO], 1u); break; } }
    }
    nloc = mine > 0u ? mine : 1u; nx = cnt > 0u ? cnt : 1u;
}
__device__ __forceinline__ void xcd_barrier(const XcdBarrier& b) {
    asm volatile("s_waitcnt vmcnt(0)" ::: "memory");
    __syncthreads();
    if (threadIdx.x == 0) {
        unsigned* bar = b.bar;
        __builtin_amdgcn_s_waitcnt(0);
        unsigned nloc = b.st[0], nx = b.st[1];
        if (nloc == 0u) { xcd_barrier_complete(bar, b.x, nloc, nx); b.st[0] = nloc; b.st[1] = nx; }
        const unsigned old = xb_add(&bar[XB_XSUB(b.x)], 1u);
        const unsigned gen = old / nloc;
        if (old + 1u == (gen + 1u) * nloc) {
            __builtin_amdgcn_fence(__ATOMIC_RELEASE, "agent");
            asm volatile("s_waitcnt vmcnt(0)" ::: "memory");
            const unsigned og = xb_add(&bar[XB_TOP], 1u);
            const unsigned tg = og / nx;
            if (og + 1u == (tg + 1u) * nx) xb_add(&bar[XB_TOPGEN], 1u);
            else XB_SPIN(xb_ld(&bar[XB_TOPGEN]) == tg, bar);
            __builtin_amdgcn_fence(__ATOMIC_ACQUIRE, "agent");
            xb_add(&bar[XB_XGEN(b.x)], 1u);
            asm volatile("s_waitcnt vmcnt(0)" ::: "memory");
        } else {
            XB_SPIN(xb_ld(&bar[XB_XGEN(b.x)]) == gen, bar);
            __builtin_amdgcn_fence(__ATOMIC_ACQUIRE, "agent");
            asm volatile("s_waitcnt vmcnt(0)" ::: "memory");
        }
    }
    __syncthreads();
}

namespace pg8 {
constexpr int BM = 256, BK = 64, HALF = 128, HTB = HALF * BK * 2, STAGE_BYTES = 8 * HTB, NXCD = 8, WGM = 8;
__host__ __device__ __forceinline__ int lds_byte(int r, int c) { const int st = (r >> 4) * 2 + (c >> 5), rr = r & 15, cc = c & 31, ob = rr * 64 + cc * 2; return st * 1024 + (ob ^ (((ob >> 9) & 1) << 5)); }
__host__ __device__ __forceinline__ void stage_rc(int b, int& R, int& C) { const int st = b / 1024, sb = b % 1024, swz = sb ^ (((sb >> 9) & 1) << 5); R = (st >> 1) * 16 + swz / 64; C = (st & 1) * 32 + (swz % 64) / 2; }
__host__ __device__ __forceinline__ int perm32(int rho) { const int n = rho >> 4, i = rho & 15; return 8 * (i >> 2) + 4 * n + (i & 3); }

struct Unit { int pm, pn, koff; };
struct Gemm { const bf16_t* A; const bf16_t* Bt; int lda, ldb, K; };

struct Order2D {
    int nM, nN, nwg, G, c;
    __device__ void init(int nM_, int nN_, int G_, int c_) { nM = nM_; nN = nN_; nwg = nM * nN; G = G_; c = c_; }
    __device__ void tile(int L, int& pm, int& pn) const {
        int wgid = L; { const int q = nwg / NXCD, r = nwg % NXCD, xcd = wgid % NXCD, off = wgid / NXCD; wgid = (xcd < r ? xcd * (q + 1) : r * (q + 1) + (xcd - r) * q) + off; }
        const int nig = WGM * nN, gid = wgid / nig, fm = gid * WGM, gsz = (nM - fm) < WGM ? (nM - fm) : WGM;
        pm = fm + ((wgid % nig) % gsz); pn = (wgid % nig) / gsz;
    }
    __device__ bool next(int i, Unit& u) const { const long L = (long)i * G + c; if (L >= nwg) return false; tile((int)L, u.pm, u.pn); u.koff = 0; return true; }
};
struct P1Order : Order2D {
    __device__ bool next(int i, Unit& u) const { const long L = (long)i * G + c; if (L >= nwg) return false; tile((int)L, u.pm, u.pn); u.pn = (u.pn >= 4 && u.pn < 8) ? (u.pn ^ 2) : u.pn; u.koff = 0; return true; }
};
struct ProjOrder : Order2D {
    __device__ bool next(int i, Unit& u) const { const long L = (long)(i >> 1) * G + c; if (L >= nwg) return false; tile((int)L, u.pm, u.pn); u.koff = (i & 1) * 1024; return true; }
};

typedef int i32x8 __attribute__((ext_vector_type(8)));
template <class Epi, class Sched, bool FP8 = false>
__device__ __forceinline__ void gemm_phase(LAS unsigned char* lds, const Gemm g, const Sched& S, const Epi& E) {
    const int tid = threadIdx.x, wid = __builtin_amdgcn_readfirstlane(tid >> 6), lane = tid & 63, wr = wid >> 2, wc = wid & 3, fr = lane & 15, fq = lane >> 4;
    const int nt = g.K / BK;
    unsigned voffA[2], voffB[2];
#pragma unroll
    for (int i = 0; i < 2; ++i) { int R, C; stage_rc(tid * 16 + i * 8192, R, C); const int Rb = Epi::PERM ? ((R & ~31) + perm32(R & 31)) : R;
        voffA[i] = (unsigned)(R * g.lda + C) * 2u; voffB[i] = (unsigned)(Rb * g.ldb + C) * 2u; }
    const size_t kstep = (size_t)(BK * 2);
    const size_t hstepA = (size_t)HALF * g.lda * 2, hstepB = (size_t)HALF * g.ldb * 2;
    const size_t tstepA = 2 * hstepA, tstepB = 2 * hstepB;
    const unsigned ldsw = (unsigned)wid * 1024u;
    const int aoff = lds_byte(wr * 64 + fr, fq * 8), boff = lds_byte(wc * 32 + fr, fq * 8);
#define PG8_SA(b, h) (((b) * 2 + (h)) * HTB)
#define PG8_SB(b, h) ((4 + (b) * 2 + (h)) * HTB)
#define PG8_STAGE(bufoff, gbase, voff) do { _Pragma("unroll") for (int _i = 0; _i < 2; ++_i) \
        __builtin_amdgcn_global_load_lds((const unsigned*)((const char*)(gbase) + (voff)[_i]), (LAS unsigned*)(lds + (bufoff) + ldsw + _i * 8192), 16, 0, 0); } while (0)
#define PG8_LDA(dst, b, h) do { _Pragma("unroll") for (int m = 0; m < 4; ++m) { dst[m].lo = *(const LAS bf16x8*)(lds + PG8_SA(b, h) + aoff + m * 2048); dst[m].hi = *(const LAS bf16x8*)(lds + PG8_SA(b, h) + aoff + m * 2048 + 1024); } } while (0)
#define PG8_LDB(dst, b, h) do { _Pragma("unroll") for (int n = 0; n < 2; ++n) { dst[n].lo = *(const LAS bf16x8*)(lds + PG8_SB(b, h) + boff + n * 2048); dst[n].hi = *(const LAS bf16x8*)(lds + PG8_SB(b, h) + boff + n * 2048 + 1024); } } while (0)
#define PG8_MMA(ai, bj, At, Bt) do { __builtin_amdgcn_s_setprio(1); _Pragma("unroll") for (int m = 0; m < 4; ++m) _Pragma("unroll") for (int n = 0; n < 2; ++n) { \
        if constexpr (FP8) { asm volatile("v_mfma_scale_f32_16x16x128_f8f6f4 %0, %1, %2, %0, %3, %3 op_sel_hi:[0,0,0]" : "+v"(acc[ai][bj][m][n]) : "v"(__builtin_bit_cast(i32x8, Bt[n])), "v"(__builtin_bit_cast(i32x8, At[m])), "v"(0x7F7F7F7F)); }     \
        else { acc[ai][bj][m][n] = __builtin_amdgcn_mfma_f32_16x16x32_bf16(Bt[n].lo, At[m].lo, acc[ai][bj][m][n], 0, 0, 0); acc[ai][bj][m][n] = __builtin_amdgcn_mfma_f32_16x16x32_bf16(Bt[n].hi, At[m].hi, acc[ai][bj][m][n], 0, 0, 0); } } __builtin_amdgcn_s_setprio(0); } while (0)
#define PG8_WAIT_V(n) asm volatile("s_waitcnt vmcnt(" #n ")" ::: "memory")
#define PG8_WAIT_L(n) asm volatile("s_waitcnt lgkmcnt(" #n ")" ::: "memory")
#define PG8_BAR __builtin_amdgcn_s_barrier()
#define PG8_SCHED __builtin_amdgcn_sched_barrier(0)
#define PG8_FENCE do { } while (0)
    Unit cur, nxt; int ui = 0;
    if (!S.next(0, cur)) return;
    f32x4 acc[2][2][4][2];
#pragma unroll
    for (int a = 0; a < 2; ++a)
#pragma unroll
        for (int b = 0; b < 2; ++b)
#pragma unroll
            for (int m = 0; m < 4; ++m)
#pragma unroll
                for (int n = 0; n < 2; ++n) acc[a][b][m][n] = (f32x4){0.f, 0.f, 0.f, 0.f};
    typedef short bf16x16 __attribute__((ext_vector_type(16)));
    bf16x16 At[4], B0[2], B1[2];
    const char* cA = (const char*)g.A + (size_t)cur.pm * tstepA + (size_t)cur.koff * 2; const char* cB = (const char*)g.Bt + (size_t)cur.pn * tstepB + (size_t)cur.koff * 2;
    PG8_STAGE(PG8_SB(0, 0), cB, voffB); PG8_STAGE(PG8_SB(0, 1), cB + hstepB, voffB); PG8_STAGE(PG8_SA(0, 0), cA, voffA); PG8_STAGE(PG8_SA(0, 1), cA + hstepA, voffA);
    if (wr == 1) PG8_BAR;
    PG8_WAIT_V(2); PG8_BAR;
    PG8_STAGE(PG8_SB(1, 0), cB + kstep, voffB); PG8_STAGE(PG8_SA(1, 0), cA + kstep, voffA); PG8_STAGE(PG8_SB(1, 1), cB + hstepB + kstep, voffB);
    PG8_WAIT_V(6); PG8_BAR;
    for (;;) {
        const bool has_next = S.next(ui + 1, nxt);
        const char* nA = has_next ? (const char*)g.A + (size_t)nxt.pm * tstepA + (size_t)nxt.koff * 2 : cA; const char* nB = has_next ? (const char*)g.Bt + (size_t)nxt.pn * tstepB + (size_t)nxt.koff * 2 : cB;
        for (int t = 0; t < nt; t += 2) {
            if constexpr (Epi::MID) { if (t == nt / 2) E.mid(acc, cur, wr, wc, fr, fq); }
            const bool last = (t == nt - 2);
            const char* a1 = cA + (size_t)(t + 1) * kstep;
            const char* a2 = last ? nA : cA + (size_t)(t + 2) * kstep; const char* b2 = last ? nB : cB + (size_t)(t + 2) * kstep;
            const char* a3 = a2 + kstep; const char* b3 = b2 + kstep;
            PG8_LDB(B0, 0, 0); PG8_LDB(B1, 0, 1); PG8_SCHED; PG8_LDA(At, 0, 0); PG8_STAGE(PG8_SA(1, 1), a1 + hstepA, voffA);
            PG8_WAIT_V(8); PG8_WAIT_L(0); PG8_BAR; PG8_MMA(0, 0, At, B0); PG8_MMA(0, 1, At, B1); PG8_FENCE; PG8_BAR; PG8_SCHED;
            PG8_LDA(At, 0, 1); PG8_STAGE(PG8_SB(0, 0), b2, voffB); PG8_STAGE(PG8_SB(0, 1), b2 + hstepB, voffB); PG8_STAGE(PG8_SA(0, 0), a2, voffA);
            PG8_WAIT_V(8); PG8_WAIT_L(0); PG8_BAR; PG8_MMA(1, 0, At, B0); PG8_MMA(1, 1, At, B1); PG8_FENCE; PG8_BAR; PG8_SCHED;
            PG8_LDB(B0, 1, 0); PG8_LDB(B1, 1, 1); PG8_SCHED; PG8_LDA(At, 1, 0); PG8_STAGE(PG8_SA(0, 1), a2 + hstepA, voffA);
            PG8_WAIT_V(8); PG8_WAIT_L(0); PG8_BAR; PG8_MMA(0, 0, At, B0); PG8_MMA(0, 1, At, B1); PG8_FENCE; PG8_BAR; PG8_SCHED;
            PG8_LDA(At, 1, 1); PG8_STAGE(PG8_SB(1, 0), b3, voffB); PG8_STAGE(PG8_SB(1, 1), b3 + hstepB, voffB); PG8_STAGE(PG8_SA(1, 0), a3, voffA);
            PG8_WAIT_V(8); PG8_WAIT_L(0); PG8_BAR; PG8_MMA(1, 0, At, B0); PG8_MMA(1, 1, At, B1); PG8_FENCE; PG8_BAR; PG8_SCHED;
        }
        if (wr == 0) PG8_BAR;
        if constexpr (FP8) asm volatile("s_nop 15\n\ts_nop 15\n\ts_nop 15\n\ts_nop 15\n\ts_nop 15\n\ts_nop 15" ::: "memory");
        E(acc, cur, wr, wc, fr, fq, ui);
        if (!has_next) break;
#pragma unroll
        for (int a = 0; a < 2; ++a)
#pragma unroll
            for (int b = 0; b < 2; ++b)
#pragma unroll
                for (int m = 0; m < 4; ++m)
#pragma unroll
                    for (int n = 0; n < 2; ++n) acc[a][b][m][n] = (f32x4){0.f, 0.f, 0.f, 0.f};
        cur = nxt; cA = nA; cB = nB; ++ui;
        if (wr == 1) PG8_BAR;
    }
    PG8_WAIT_V(0);
    PG8_BAR;
#undef PG8_SA
#undef PG8_SB
#undef PG8_STAGE
#undef PG8_LDA
#undef PG8_LDB
#undef PG8_MMA
#undef PG8_WAIT_V
#undef PG8_WAIT_L
#undef PG8_BAR
#undef PG8_SCHED
#undef PG8_FENCE
}

struct Epi1 {
    static constexpr bool PERM = true, MID = false;
    const float* rsx; const float* sw; bf16_t *q, *k, *v, *gu, *gv, *gates; const float* b_gate; float* ssqv; const float* k_norm; LAS float* xch; bf16_t* kraw_dbg; unsigned char* vt8;
    __device__ __forceinline__ void k_tile(f32x4 (&acc)[2][2][4][2], const Unit& u, int wr, int wc, int fr, int fq) const {
        const int rl0 = wr * 64 + fr, cb = wc * 32 + 8 * fq;
        float rsv[2][4];
#pragma unroll
        for (int ai = 0; ai < 2; ++ai)
#pragma unroll
            for (int m = 0; m < 4; ++m) rsv[ai][m] = rsx[u.pm * BM + rl0 + ai * HALF + m * 16];
        f32x4 swv[2][2];
#pragma unroll
        for (int bj = 0; bj < 2; ++bj)
#pragma unroll
            for (int n = 0; n < 2; ++n) swv[bj][n] = *(const f32x4*)(sw + 4 * BM + bj * HALF + cb + 4 * n);
#pragma unroll
        for (int ai = 0; ai < 2; ++ai)
#pragma unroll
            for (int m = 0; m < 4; ++m)
#pragma unroll
                for (int bj = 0; bj < 2; ++bj) { const f32x4 v0 = acc[ai][bj][m][0] * rsv[ai][m] * swv[bj][0], v1 = acc[ai][bj][m][1] * rsv[ai][m] * swv[bj][1];
                    acc[ai][bj][m][0] = v0; acc[ai][bj][m][1] = v1;
                    float ss = (v0[0] * v0[0] + v0[1] * v0[1]) + (v0[2] * v0[2] + v0[3] * v0[3]) + (v1[0] * v1[0] + v1[1] * v1[1]) + (v1[2] * v1[2] + v1[3] * v1[3]);
                    ss += __shfl_xor(ss, 16); ss += __shfl_xor(ss, 32);
                    if (fq == 0) xch[((rl0 + ai * HALF + m * 16) * 2 + bj) * 4 + wc] = ss; }
        asm volatile("s_waitcnt lgkmcnt(0)" ::: "memory"); __builtin_amdgcn_s_barrier(); asm volatile("" ::: "memory");
        const f32x4 g0 = *(const f32x4*)(k_norm + cb), g1 = *(const f32x4*)(k_norm + cb + 4);
        float inv[4];
#pragma unroll
        for (int jj = 0; jj < 4; ++jj) inv[jj] = __builtin_amdgcn_exp2f(-(float)(16 * (wc & 1) + 4 * fq + jj) * (13.287712379549449f / 32.0f)) * 0.15915494309189535f;
#pragma unroll
        for (int ai = 0; ai < 2; ++ai)
#pragma unroll
            for (int m = 0; m < 4; ++m) {
                const int rl = rl0 + ai * HALF + m * 16, t = u.pm * BM + rl;
                const float pos = (float)((wc < 2) ? (t >> 6) : (t & 63));
                float cs[4], sn[4];
#pragma unroll
                for (int jj = 0; jj < 4; ++jj) { const float rev = pos * inv[jj], fr_ = rev - floorf(rev); cs[jj] = __builtin_amdgcn_cosf(fr_); sn[jj] = __builtin_amdgcn_sinf(fr_); }
#pragma unroll
                for (int bj = 0; bj < 2; ++bj) {
                    const f32x4 pp = *(const LAS f32x4*)(xch + (rl * 2 + bj) * 4);
                    const float rs = 1.0f / sqrtf(((pp[0] + pp[1]) + (pp[2] + pp[3])) * (1.0f / HD) + EPS);
                    const f32x4 z0 = acc[ai][bj][m][0], z1 = acc[ai][bj][m][1];
                    if (kraw_dbg) { u32x4 w; w.x = cvt_pk_bf16(z0[0], z0[1]); w.y = cvt_pk_bf16(z0[2], z0[3]); w.z = cvt_pk_bf16(z1[0], z1[1]); w.w = cvt_pk_bf16(z1[2], z1[3]); *(u32x4*)(kraw_dbg + (size_t)t * KVW + bj * HALF + cb) = w; }
                    const f32x4 y0 = z0 * rs * g0, y1 = z1 * rs * g1;
                    f32x4 e0, e1;
                    e0[0] = y0[0] * cs[0] - y0[1] * sn[0]; e0[1] = y0[0] * sn[0] + y0[1] * cs[0]; e0[2] = y0[2] * cs[1] - y0[3] * sn[1]; e0[3] = y0[2] * sn[1] + y0[3] * cs[1];
                    e1[0] = y1[0] * cs[2] - y1[1] * sn[2]; e1[1] = y1[0] * sn[2] + y1[1] * cs[2]; e1[2] = y1[2] * cs[3] - y1[3] * sn[3]; e1[3] = y1[2] * sn[3] + y1[3] * cs[3];
                    TRANS_FENCE2(e0, e1);
                    int w0 = 0, w1 = 0;
                    w0 = __builtin_amdgcn_cvt_pk_fp8_f32(sat8(e0[0]), sat8(e0[1]), w0, false); w0 = __builtin_amdgcn_cvt_pk_fp8_f32(sat8(e0[2]), sat8(e0[3]), w0, true);
                    w1 = __builtin_amdgcn_cvt_pk_fp8_f32(sat8(e1[0]), sat8(e1[1]), w1, false); w1 = __builtin_amdgcn_cvt_pk_fp8_f32(sat8(e1[2]), sat8(e1[3]), w1, true);
                    u32x2 w; w.x = (unsigned)w0; w.y = (unsigned)w1;
                    *(u32x2*)((unsigned char*)k + (size_t)t * KVW + bj * HALF + (wc >> 1) * 64 + (fq & 1) * 32 + ((wc & 1) * 2 + (fq >> 1)) * 8) = w;
                }
            }
    }
    __device__ __forceinline__ void v_tile(const f32x4 (&acc)[2][2][4][2], const Unit& u, int wr, int wc, int fr, int fq) const {
        asm volatile("" : "+v"(fr), "+v"(fq));
        const int row0 = u.pm * BM + wr * 64 + fr, cw = wc * 32 + 8 * fq;
#pragma unroll
        for (int ai = 0; ai < 2; ++ai)
#pragma unroll
            for (int m = 0; m < 4; ++m) {
                const int r = row0 + ai * HALF + m * 16; const float rs = rsx[r];
                const int kk = r & 63, pos = ((kk >> 2) & 1) * 32 + (kk >> 5) * 16 + (kk & 3) + 4 * ((kk & 31) >> 3);
#pragma unroll
                for (int bj = 0; bj < 2; ++bj) {
                    const f32x4 s0 = *(const f32x4*)(sw + 5 * BM + bj * HALF + cw), s1 = *(const f32x4*)(sw + 5 * BM + bj * HALF + cw + 4);
                    const f32x4 v0 = acc[ai][bj][m][0] * rs * s0, v1 = acc[ai][bj][m][1] * rs * s1;
                    u32x4 w; w.x = cvt_pk_bf16(v0[0], v0[1]); w.y = cvt_pk_bf16(v0[2], v0[3]); w.z = cvt_pk_bf16(v1[0], v1[1]); w.w = cvt_pk_bf16(v1[2], v1[3]);
                    *(u32x4*)(v + (size_t)r * KVW + bj * HALF + cw) = w;
                    unsigned char* vp = vt8 + (((size_t)(r >> 6) * 2 + bj) * 128 + cw) * 64 + pos;
                    int f0 = 0, f1 = 0;
                    f0 = __builtin_amdgcn_cvt_pk_fp8_f32(sat8(v0[0]), sat8(v0[1]), f0, false); f0 = __builtin_amdgcn_cvt_pk_fp8_f32(sat8(v0[2]), sat8(v0[3]), f0, true);
                    f1 = __builtin_amdgcn_cvt_pk_fp8_f32(sat8(v1[0]), sat8(v1[1]), f1, false); f1 = __builtin_amdgcn_cvt_pk_fp8_f32(sat8(v1[2]), sat8(v1[3]), f1, true);
                    vp[0] = (unsigned char)f0; vp[64] = (unsigned char)(f0 >> 8); vp[128] = (unsigned char)(f0 >> 16); vp[192] = (unsigned char)(f0 >> 24);
                    vp[256] = (unsigned char)f1; vp[320] = (unsigned char)(f1 >> 8); vp[384] = (unsigned char)(f1 >> 16); vp[448] = (unsigned char)(f1 >> 24);
                }
                __builtin_amdgcn_sched_barrier(0);
            }
    }
    __device__ __forceinline__ void operator()(f32x4 (&acc)[2][2][4][2], const Unit& u, int wr, int wc, int fr, int fq, int) const {
        if (u.pn == 4) { k_tile(acc, u, wr, wc, fr, fq); return; }
        if (u.pn == 5) { v_tile(acc, u, wr, wc, fr, fq); return; }
        const int row0 = u.pm * BM + wr * 64 + fr, pn = u.pn;
        bf16_t* dst; int ldc, colt, mode;
        if (pn < 4) { dst = q; ldc = QW; colt = pn * 256; mode = 0; }
        else if (pn == 5) { dst = v; ldc = KVW; colt = 0; mode = 0; }
        else if (pn < 10) { dst = gu; ldc = SGW; colt = (pn - 6) * 256; mode = 1; }
        else if (pn < 14) { dst = gv; ldc = SGW; colt = (pn - 10) * 256; mode = 2; }
        else { dst = gates; ldc = 4096; colt = (pn - 14) * 256; mode = 3; }
        const int cw = wc * 32 + 8 * fq, col0 = colt + cw;
        float rsv[2][4];
#pragma unroll
        for (int ai = 0; ai < 2; ++ai)
#pragma unroll
            for (int m = 0; m < 4; ++m) rsv[ai][m] = rsx[row0 + ai * HALF + m * 16];
        f32x4 bv[2][2], swv[2][2];
#pragma unroll
        for (int bj = 0; bj < 2; ++bj)
#pragma unroll
            for (int n = 0; n < 2; ++n) { bv[bj][n] = (mode == 3) ? *(const f32x4*)(b_gate + col0 + bj * HALF + 4 * n) : (f32x4){0.f, 0.f, 0.f, 0.f};
                swv[bj][n] = *(const f32x4*)(sw + pn * BM + cw + bj * HALF + 4 * n); }
#pragma unroll
        for (int ai = 0; ai < 2; ++ai)
#pragma unroll
            for (int m = 0; m < 4; ++m) {
                const int r = row0 + ai * HALF + m * 16; const float rs = rsv[ai][m];
                bf16_t* rowp = dst + (size_t)r * ldc + col0; float ss = 0.f;
#pragma unroll
                for (int bj = 0; bj < 2; ++bj) {
                    f32x4 v0 = acc[ai][bj][m][0] * rs * swv[bj][0], v1 = acc[ai][bj][m][1] * rs * swv[bj][1];
                    if (mode == 1 || mode == 2) {
#pragma unroll
                        for (int j = 0; j < 4; ++j) { v0[j] = gelu_tanh(v0[j]); v1[j] = gelu_tanh(v1[j]); }
                        if (mode == 2) {
#pragma unroll
                            for (int j = 0; j < 4; ++j) ss += v0[j] * v0[j] + v1[j] * v1[j];
                        }
                    } else if (mode == 3) {
                        v0 = v0 + bv[bj][0]; v1 = v1 + bv[bj][1];
#pragma unroll
                        for (int j = 0; j < 4; ++j) { v0[j] = sigmoidf_(v0[j]); v1[j] = sigmoidf_(v1[j]); }
                    }
                    TRANS_FENCE2(v0, v1);
                    u32x4 w; w.x = cvt_pk_bf16(v0[0], v0[1]); w.y = cvt_pk_bf16(v0[2], v0[3]); w.z = cvt_pk_bf16(v1[0], v1[1]); w.w = cvt_pk_bf16(v1[2], v1[3]);
                    *(u32x4*)(rowp + bj * HALF) = w;
                }
                if (mode == 2) { ss += __shfl_xor(ss, 16); ss += __shfl_xor(ss, 32); if (fq == 0) ssqv[(size_t)r * 16 + (pn - 10) * 4 + wc] = ss; }
            }
    }
};
struct Epi3 {
    static constexpr bool PERM = true, MID = true;
    unsigned char* ws;
    __device__ __forceinline__ void mid(f32x4 (&acc)[2][2][4][2], const Unit& u, int wr, int wc, int fr, int fq) const {
        asm volatile("" : "+v"(fr), "+v"(fq));
        const int row0 = u.pm * BM + wr * 64 + fr, col0 = u.pn * BM + wc * 32 + 8 * fq;
        const bf16_t* gates = (const bf16_t*)(ws + WS_F);
#pragma unroll
        for (int ai = 0; ai < 2; ++ai) {
            u32x4 ga[4][2], gs[4][2];
#pragma unroll
            for (int m = 0; m < 4; ++m)
#pragma unroll
                for (int bj = 0; bj < 2; ++bj) { const int r = row0 + ai * HALF + m * 16;
                    ga[m][bj] = __builtin_nontemporal_load((const u32x4*)(gates + (size_t)r * 4096 + col0 + bj * HALF));
                    gs[m][bj] = *(const u32x4*)(gates + (size_t)r * 4096 + 2048 + col0 + bj * HALF); }
#pragma unroll
            for (int m = 0; m < 4; ++m)
#pragma unroll
                for (int bj = 0; bj < 2; ++bj) { const u32x4 a = ga[m][bj], g = gs[m][bj];
                    f32x4 r0, r1;
                    r0[0] = bf_lo(a.x) * __builtin_amdgcn_rcpf(fmaxf(bf_lo(g.x), 1e-18f)); r0[1] = bf_hi(a.x) * __builtin_amdgcn_rcpf(fmaxf(bf_hi(g.x), 1e-18f));
                    r0[2] = bf_lo(a.y) * __builtin_amdgcn_rcpf(fmaxf(bf_lo(g.y), 1e-18f)); r0[3] = bf_hi(a.y) * __builtin_amdgcn_rcpf(fmaxf(bf_hi(g.y), 1e-18f));
                    r1[0] = bf_lo(a.z) * __builtin_amdgcn_rcpf(fmaxf(bf_lo(g.z), 1e-18f)); r1[1] = bf_hi(a.z) * __builtin_amdgcn_rcpf(fmaxf(bf_hi(g.z), 1e-18f));
                    r1[2] = bf_lo(a.w) * __builtin_amdgcn_rcpf(fmaxf(bf_lo(g.w), 1e-18f)); r1[3] = bf_hi(a.w) * __builtin_amdgcn_rcpf(fmaxf(bf_hi(g.w), 1e-18f));
                    acc[ai][bj][m][0] = acc[ai][bj][m][0] * r0; acc[ai][bj][m][1] = acc[ai][bj][m][1] * r1; }
        }
    }
    __device__ __forceinline__ void operator()(const f32x4 (&acc)[2][2][4][2], const Unit& u, int wr, int wc, int fr, int fq, int) const {
        const int row0 = u.pm * BM + wr * 64 + fr, col0 = u.pn * BM + wc * 32 + 8 * fq;
        const bf16_t* gates = (const bf16_t*)(ws + WS_F) + 2048;
        bf16_t* dst = (bf16_t*)(ws + WS_B);
#pragma unroll
        for (int ai = 0; ai < 2; ++ai) {
            u32x4 gw[4][2];
#pragma unroll
            for (int m = 0; m < 4; ++m)
#pragma unroll
                for (int bj = 0; bj < 2; ++bj) { const int r = row0 + ai * HALF + m * 16; gw[m][bj] = __builtin_nontemporal_load((const u32x4*)(gates + (size_t)r * 4096 + col0 + bj * HALF)); }
#pragma unroll
            for (int m = 0; m < 4; ++m)
#pragma unroll
                for (int bj = 0; bj < 2; ++bj) { const int r = row0 + ai * HALF + m * 16;
                    const u32x4 g = gw[m][bj];
                    f32x4 v0 = acc[ai][bj][m][0], v1 = acc[ai][bj][m][1];
                    v0[0] *= fmaxf(bf_lo(g.x), 1e-18f); v0[1] *= fmaxf(bf_hi(g.x), 1e-18f); v0[2] *= fmaxf(bf_lo(g.y), 1e-18f); v0[3] *= fmaxf(bf_hi(g.y), 1e-18f);
                    v1[0] *= fmaxf(bf_lo(g.z), 1e-18f); v1[1] *= fmaxf(bf_hi(g.z), 1e-18f); v1[2] *= fmaxf(bf_lo(g.w), 1e-18f); v1[3] *= fmaxf(bf_hi(g.w), 1e-18f);
                    u32x4 w; w.x = cvt_pk_bf16(v0[0], v0[1]); w.y = cvt_pk_bf16(v0[2], v0[3]); w.z = cvt_pk_bf16(v1[0], v1[1]); w.w = cvt_pk_bf16(v1[2], v1[3]);
                    *(u32x4*)(dst + (size_t)r * DM + col0 + bj * HALF) = w; }
        }
    }
};
struct Epi4 {
    static constexpr bool PERM = true, MID = false;
    const float* x; float* out; bf16_t* h1b; float* ssq2;
    __device__ __forceinline__ void operator()(const f32x4 (&acc)[2][2][4][2], const Unit& u, int wr, int wc, int fr, int fq, int) const {
        const int row0 = u.pm * BM + wr * 64 + fr, col0 = u.pn * BM + wc * 32 + 8 * fq;
#pragma unroll
        for (int ai = 0; ai < 2; ++ai) {
            f32x4 xv[4][2][2];
#pragma unroll
            for (int m = 0; m < 4; ++m)
#pragma unroll
                for (int bj = 0; bj < 2; ++bj) { const size_t off = (size_t)(row0 + ai * HALF + m * 16) * DM + col0 + bj * HALF;
                    xv[m][bj][0] = __builtin_nontemporal_load((const f32x4*)(x + off)); xv[m][bj][1] = __builtin_nontemporal_load((const f32x4*)(x + off + 4)); }
#pragma unroll
            for (int m = 0; m < 4; ++m) {
                const int r = row0 + ai * HALF + m * 16; float ss = 0.f;
#pragma unroll
                for (int bj = 0; bj < 2; ++bj) {
                    const size_t off = (size_t)r * DM + col0 + bj * HALF;
                    const f32x4 v0 = acc[ai][bj][m][0] + xv[m][bj][0], v1 = acc[ai][bj][m][1] + xv[m][bj][1];
#pragma unroll
                    for (int j = 0; j < 4; ++j) ss += v0[j] * v0[j] + v1[j] * v1[j];
                    u32x4 w; w.x = cvt_pk_bf16(v0[0], v0[1]); w.y = cvt_pk_bf16(v0[2], v0[3]); w.z = cvt_pk_bf16(v1[0], v1[1]); w.w = cvt_pk_bf16(v1[2], v1[3]);
                    *(u32x4*)(h1b + off) = w;
                }
                ss += __shfl_xor(ss, 16); ss += __shfl_xor(ss, 32);
                if (fq == 0) ssq2[(size_t)r * 32 + u.pn * 4 + wc] = ss;
            }
        }
    }
};
struct Epi5 {
    static constexpr bool PERM = true, MID = false;
    const LAS float* rs2; bf16_t* qp;
    __device__ __forceinline__ void operator()(const f32x4 (&acc)[2][2][4][2], const Unit& u, int wr, int wc, int fr, int fq, int ui) const {
        const int rl0 = wr * 64 + fr, col0 = u.pn * BM + wc * 32 + 8 * fq;
#pragma unroll
        for (int ai = 0; ai < 2; ++ai)
#pragma unroll
            for (int m = 0; m < 4; ++m) {
                const int rl = rl0 + ai * HALF + m * 16; const float rs = rs2[ui * 256 + rl];
#pragma unroll
                for (int bj = 0; bj < 2; ++bj) {
                    const f32x4 v0 = acc[ai][bj][m][0] * rs, v1 = acc[ai][bj][m][1] * rs;
                    u32x4 w; w.x = cvt_pk_bf16(v0[0], v0[1]); w.y = cvt_pk_bf16(v0[2], v0[3]); w.z = cvt_pk_bf16(v1[0], v1[1]); w.w = cvt_pk_bf16(v1[2], v1[3]);
                    *(u32x4*)(qp + (size_t)(u.pm * BM + rl) * DM + col0 + bj * HALF) = w;
                }
            }
    }
};
}

namespace att {
constexpr int D = 128, NW = 8, QBLK = 32, KVBLK = 64;
constexpr float SCALE = 0.088388347648318440f;
constexpr int LDQ = QW, LDK = KVW, LDO = 2048;
#define SBAR() __builtin_amdgcn_sched_barrier(0)
__device__ __forceinline__ int crow(int r, int hi) { return (r & 3) + 8 * (r >> 2) + 4 * hi; }
#define KSWZ8(row, colB) ((row) * 128 + ((colB) ^ ((((row) >> 1) & 7) << 4)))
typedef int i32x8 __attribute__((ext_vector_type(8)));
__device__ __forceinline__ void qkt8(f32x16& p0, f32x16& p1, const char* Ks, const i32x8 (&q8)[2], int r32, int hi, const f32x16& cinit) {
  p0 = cinit; p1 = cinit;
#pragma unroll
  for (int c = 0; c < 2; ++c) { const int cb = c * 64 + hi * 32;
    const u32x4 a0 = *reinterpret_cast<const u32x4*>(Ks + KSWZ8(r32, cb)), a1 = *reinterpret_cast<const u32x4*>(Ks + KSWZ8(r32, cb + 16));
    const u32x4 b0 = *reinterpret_cast<const u32x4*>(Ks + KSWZ8(32 + r32, cb)), b1 = *reinterpret_cast<const u32x4*>(Ks + KSWZ8(32 + r32, cb + 16));
    const i32x8 ka = {(int)a0.x, (int)a0.y, (int)a0.z, (int)a0.w, (int)a1.x, (int)a1.y, (int)a1.z, (int)a1.w}, kb2 = {(int)b0.x, (int)b0.y, (int)b0.z, (int)b0.w, (int)b1.x, (int)b1.y, (int)b1.z, (int)b1.w};
    p0 = __builtin_amdgcn_mfma_scale_f32_32x32x64_f8f6f4(ka, q8[c], p0, 0, 0, 0, 0, 0, 0);
    p1 = __builtin_amdgcn_mfma_scale_f32_32x32x64_f8f6f4(kb2, q8[c], p1, 0, 0, 0, 0, 0, 0); }
}
#define VSWZ8(d, chunk) ((d) * 64 + ((((chunk) ^ (((d) >> 2) & 3))) << 4))
__device__ __forceinline__ void pv8(f32x16* o, f32x16& lsum, const i32x8& ones8, const char* Vs, const i32x8& pa, int r32, int hi) {
  lsum = __builtin_amdgcn_mfma_scale_f32_32x32x64_f8f6f4(ones8, pa, lsum, 0, 0, 0, 0, 0, 0);
  const char* vb = Vs + VSWZ8(r32, 2 * hi); const char* vb1 = Vs + VSWZ8(r32, 2 * hi + 1);
#pragma unroll
  for (int d0 = 0; d0 < 4; ++d0) {
    const u32x4 a0 = *reinterpret_cast<const u32x4*>(vb + d0 * 2048), a1 = *reinterpret_cast<const u32x4*>(vb1 + d0 * 2048);
    const i32x8 vf = {(int)a0.x, (int)a0.y, (int)a0.z, (int)a0.w, (int)a1.x, (int)a1.y, (int)a1.z, (int)a1.w};
    o[d0] = __builtin_amdgcn_mfma_scale_f32_32x32x64_f8f6f4(vf, pa, o[d0], 0, 0, 0, 0, 0, 0); }
}
template <int SOFF> __device__ __forceinline__ void qkt8o(f32x16& p0, f32x16& p1, const char* ldsb, const int (&ko)[4], const i32x8 (&q8)[2], const f32x16& cinit) {
  p0 = cinit; p1 = cinit;
#pragma unroll
  for (int c = 0; c < 2; ++c) {
    const u32x4 a0 = *reinterpret_cast<const u32x4*>(ldsb + ko[2 * c] + SOFF), a1 = *reinterpret_cast<const u32x4*>(ldsb + ko[2 * c + 1] + SOFF);
    const u32x4 b0 = *reinterpret_cast<const u32x4*>(ldsb + ko[2 * c] + SOFF + 4096), b1 = *reinterpret_cast<const u32x4*>(ldsb + ko[2 * c + 1] + SOFF + 4096);
    const i32x8 ka = {(int)a0.x, (int)a0.y, (int)a0.z, (int)a0.w, (int)a1.x, (int)a1.y, (int)a1.z, (int)a1.w}, kb2 = {(int)b0.x, (int)b0.y, (int)b0.z, (int)b0.w, (int)b1.x, (int)b1.y, (int)b1.z, (int)b1.w};
    p0 = __builtin_amdgcn_mfma_scale_f32_32x32x64_f8f6f4(ka, q8[c], p0, 0, 0, 0, 0, 0, 0);
    p1 = __builtin_amdgcn_mfma_scale_f32_32x32x64_f8f6f4(kb2, q8[c], p1, 0, 0, 0, 0, 0, 0); }
}
template <int SOFF> __device__ __forceinline__ void pv8o(f32x16* o, f32x16& lsum, const i32x8& ones8, const char* ldsb, const int (&vo)[2], const i32x8& pa) {
  lsum = __builtin_amdgcn_mfma_scale_f32_32x32x64_f8f6f4(ones8, pa, lsum, 0, 0, 0, 0, 0, 0);
#pragma unroll
  for (int d0 = 0; d0 < 4; ++d0) {
    const u32x4 a0 = *reinterpret_cast<const u32x4*>(ldsb + vo[0] + SOFF + d0 * 2048), a1 = *reinterpret_cast<const u32x4*>(ldsb + vo[1] + SOFF + d0 * 2048);
    const i32x8 vf = {(int)a0.x, (int)a0.y, (int)a0.z, (int)a0.w, (int)a1.x, (int)a1.y, (int)a1.z, (int)a1.w};
    o[d0] = __builtin_amdgcn_mfma_scale_f32_32x32x64_f8f6f4(vf, pa, o[d0], 0, 0, 0, 0, 0, 0); }
}
constexpr float THR8 = 2.5f, POFF8 = 6.0f;
__device__ __forceinline__ void partialSM8(f32x16& p0, f32x16& p1, f32x16& cinit, float& alpha, bool first) {
  float pmax = p0[0]; for (int r = 1; r < 16; ++r) pmax = fmaxf(pmax, p0[r]); for (int r = 0; r < 16; ++r) pmax = fmaxf(pmax, p1[r]);
  { auto rr = __builtin_amdgcn_permlane32_swap(__float_as_uint(pmax), __float_as_uint(pmax), false, false);
    pmax = fmaxf(__uint_as_float(rr[0]), __uint_as_float(rr[1])); }
  if (__builtin_expect(!first && __all(pmax <= POFF8 + THR8), 1)) alpha = 1.f;
  else { const float d = first ? pmax - POFF8 : fmaxf(pmax - POFF8, 0.f);
    alpha = __builtin_amdgcn_exp2f(-d);
    for (int r = 0; r < 16; ++r) { p0[r] -= d; p1[r] -= d; cinit[r] -= d; } }
}
__device__ __forceinline__ void finishSM8(f32x16& p0, f32x16& p1, i32x8& pa) {
  for (int r = 0; r < 16; ++r) { p0[r] = __builtin_amdgcn_exp2f(p0[r]); p1[r] = __builtin_amdgcn_exp2f(p1[r]); }
  asm volatile("s_nop 0" : "+v"(p0), "+v"(p1));
#pragma unroll
  for (int j = 0; j < 4; ++j) { int w0 = pa[j], w1 = pa[4 + j];
    w0 = __builtin_amdgcn_cvt_pk_fp8_f32(p0[4 * j], p0[4 * j + 1], w0, false); w0 = __builtin_amdgcn_cvt_pk_fp8_f32(p0[4 * j + 2], p0[4 * j + 3], w0, true);
    w1 = __builtin_amdgcn_cvt_pk_fp8_f32(p1[4 * j], p1[4 * j + 1], w1, false); w1 = __builtin_amdgcn_cvt_pk_fp8_f32(p1[4 * j + 2], p1[4 * j + 3], w1, true);
    pa[j] = w0; pa[4 + j] = w1; }
}
#define EXPQ(j) do { _Pragma("unroll") for (int r = 4 * (j); r < 4 * (j) + 4; ++r) { y0[r] = __builtin_amdgcn_exp2f(y0[r]); y1[r] = __builtin_amdgcn_exp2f(y1[r]); } } while (0)
#define PACKQ(j) do { int w0 = pa[j], w1 = pa[4 + (j)]; \
    w0 = __builtin_amdgcn_cvt_pk_fp8_f32(y0[4 * (j)], y0[4 * (j) + 1], w0, false); w0 = __builtin_amdgcn_cvt_pk_fp8_f32(y0[4 * (j) + 2], y0[4 * (j) + 3], w0, true); \
    w1 = __builtin_amdgcn_cvt_pk_fp8_f32(y1[4 * (j)], y1[4 * (j) + 1], w1, false); w1 = __builtin_amdgcn_cvt_pk_fp8_f32(y1[4 * (j) + 2], y1[4 * (j) + 3], w1, true); \
    pa[j] = w0; pa[4 + (j)] = w1; } while (0)
#define LDFRAG(dst, base, o0, o1) do { const u32x4 _a = *reinterpret_cast<const u32x4*>((base) + (o0)), _b = *reinterpret_cast<const u32x4*>((base) + (o1)); \
    dst = i32x8{(int)_a.x, (int)_a.y, (int)_a.z, (int)_a.w, (int)_b.x, (int)_b.y, (int)_b.z, (int)_b.w}; } while (0)
__device__ __forceinline__ float vmax3(float a, float b, float c) { float r; asm("v_max3_f32 %0, %1, %2, %3" : "=v"(r) : "v"(a), "v"(b), "v"(c)); return r; }
__device__ __forceinline__ float vmax2(float a, float b) { float r; asm("v_max_f32 %0, %1, %2" : "=v"(r) : "v"(a), "v"(b)); return r; }
__device__ __forceinline__ float vmax8(float a0, float a1, float a2, float a3, float a4, float a5, float a6, float a7) { float r;
  asm("v_max3_f32 %0, %1, %2, %3\n\tv_max3_f32 %0, %0, %4, %5\n\tv_max3_f32 %0, %0, %6, %7\n\tv_max_f32 %0, %0, %8" : "=&v"(r) : "v"(a0), "v"(a1), "v"(a2), "v"(a3), "v"(a4), "v"(a5), "v"(a6), "v"(a7)); return r; }
__device__ __forceinline__ float vmax11(float a0, float a1, float a2, float a3, float a4, float a5, float a6, float a7, float b0, float b1, float b2) { float r;
  asm("v_max3_f32 %0, %1, %2, %3\n\tv_max3_f32 %0, %0, %4, %5\n\tv_max3_f32 %0, %0, %6, %7\n\tv_max3_f32 %0, %0, %8, %9\n\tv_max3_f32 %0, %0, %10, %11"
      : "=&v"(r) : "v"(a0), "v"(a1), "v"(a2), "v"(a3), "v"(a4), "v"(a5), "v"(a6), "v"(a7), "v"(b0), "v"(b1), "v"(b2)); return r; }
__device__ __forceinline__ float vmax9(float m, float a0, float a1, float a2, float a3, float a4, float a5, float a6, float a7) { float r;
  asm("v_max3_f32 %0, %1, %2, %3\n\tv_max3_f32 %0, %0, %4, %5\n\tv_max3_f32 %0, %0, %6, %7\n\tv_max3_f32 %0, %0, %8, %9" : "=&v"(r) : "v"(m), "v"(a0), "v"(a1), "v"(a2), "v"(a3), "v"(a4), "v"(a5), "v"(a6), "v"(a7)); return r; }
#define MAX8(v, b) vmax8(v[b], v[b + 1], v[b + 2], v[b + 3], v[b + 4], v[b + 5], v[b + 6], v[b + 7])
template <int KOFF, int VOFF> __device__ __forceinline__ float tile_step(f32x16& x0, f32x16& x1, f32x16& y0, f32x16& y1, i32x8& pa, f32x16* o, f32x16& lsum, const i32x8& ones8,
                                                                        const char* ldsb, const int (&ko)[4], const int (&vo)[2], const i32x8 (&q8)[2], const f32x16& cinit,
                                                                        bool dma, const unsigned char* vgl, size_t voff, unsigned vlo, const unsigned char* kgl, long koff, unsigned klo, LAS unsigned char* dst, bool& quiet) {
  i32x8 ka, kb, vf, vg;
  LDFRAG(ka, ldsb + KOFF, ko[0], ko[1]); LDFRAG(kb, ldsb + KOFF + 4096, ko[0], ko[1]);
  EXPQ(0); SBAR();
  x0 = __builtin_amdgcn_mfma_scale_f32_32x32x64_f8f6f4(ka, q8[0], cinit, 0, 0, 0, 0, 0, 0); SBAR();
  EXPQ(1); PACKQ(0); SBAR();
  x1 = __builtin_amdgcn_mfma_scale_f32_32x32x64_f8f6f4(kb, q8[0], cinit, 0, 0, 0, 0, 0, 0); SBAR();
  LDFRAG(ka, ldsb + KOFF, ko[2], ko[3]); LDFRAG(kb, ldsb + KOFF + 4096, ko[2], ko[3]);
  EXPQ(2); PACKQ(1); SBAR();
  x0 = __builtin_amdgcn_mfma_scale_f32_32x32x64_f8f6f4(ka, q8[1], x0, 0, 0, 0, 0, 0, 0); SBAR();
  EXPQ(3); PACKQ(2); SBAR();
  x1 = __builtin_amdgcn_mfma_scale_f32_32x32x64_f8f6f4(kb, q8[1], x1, 0, 0, 0, 0, 0, 0); SBAR();
  LDFRAG(vf, ldsb + VOFF, vo[0], vo[1]);
  PACKQ(3); SBAR();
  lsum = __builtin_amdgcn_mfma_scale_f32_32x32x64_f8f6f4(ones8, pa, lsum, 0, 0, 0, 0, 0, 0); SBAR();
  LDFRAG(vg, ldsb + VOFF + 2048, vo[0], vo[1]);
  if (dma) { __builtin_amdgcn_global_load_lds((const unsigned*)(vgl + voff + (size_t)vlo), (LAS unsigned*)dst, 16, 0, 0);
             __builtin_amdgcn_global_load_lds((const unsigned*)(kgl + koff + (size_t)klo), (LAS unsigned*)(dst + 65536), 16, 0, 0); }
  float m0 = MAX8(x0, 0); SBAR();
  o[0] = __builtin_amdgcn_mfma_scale_f32_32x32x64_f8f6f4(vf, pa, o[0], 0, 0, 0, 0, 0, 0); SBAR();
  LDFRAG(vf, ldsb + VOFF + 4096, vo[0], vo[1]);
  const float mA = vmax9(m0, x0[8], x0[9], x0[10], x0[11], x0[12], x0[13], x0[14], x0[15]); SBAR();
  o[1] = __builtin_amdgcn_mfma_scale_f32_32x32x64_f8f6f4(vg, pa, o[1], 0, 0, 0, 0, 0, 0); SBAR();
  LDFRAG(vg, ldsb + VOFF + 6144, vo[0], vo[1]);
  float m2 = MAX8(x1, 0); SBAR();
  o[2] = __builtin_amdgcn_mfma_scale_f32_32x32x64_f8f6f4(vf, pa, o[2], 0, 0, 0, 0, 0, 0); SBAR();
  const float mB = vmax9(m2, x1[8], x1[9], x1[10], x1[11], x1[12], x1[13], x1[14], x1[15]);
  float m3;
  { auto rr = __builtin_amdgcn_permlane32_swap(__float_as_uint(mA), __float_as_uint(mB), false, false);
    m3 = vmax2(__uint_as_float(rr[0]), __uint_as_float(rr[1])); }
  quiet = __all(m3 <= POFF8 + THR8); SBAR();
  o[3] = __builtin_amdgcn_mfma_scale_f32_32x32x64_f8f6f4(vg, pa, o[3], 0, 0, 0, 0, 0, 0); SBAR();
  return m3;
}
__device__ __forceinline__ void decideSM8(float pmax, bool quiet, f32x16& p0, f32x16& p1, f32x16& cinit, float& alpha) {
  if (__builtin_expect(quiet, 1)) alpha = 1.f;
  else { { auto rr = __builtin_amdgcn_permlane32_swap(__float_as_uint(pmax), __float_as_uint(pmax), false, false);
      pmax = fmaxf(__uint_as_float(rr[0]), __uint_as_float(rr[1])); }
    const float d = fmaxf(pmax - POFF8, 0.f);
    alpha = __builtin_amdgcn_exp2f(-d);
    for (int r = 0; r < 16; ++r) { p0[r] -= d; p1[r] -= d; cinit[r] -= d; } }
}
__device__ __forceinline__ void q_to_fp8(const bf16x8 (&qr)[8], i32x8 (&q8)[2]) {
#pragma unroll
  for (int d0 = 0; d0 < 8; ++d0) { const u32x4 w = *reinterpret_cast<const u32x4*>(&qr[d0]);
    int lo = 0, hi2 = 0;
    lo = __builtin_amdgcn_cvt_pk_fp8_f32(sat8(bf_lo(w.x)), sat8(bf_hi(w.x)), lo, false); lo = __builtin_amdgcn_cvt_pk_fp8_f32(sat8(bf_lo(w.y)), sat8(bf_hi(w.y)), lo, true);
    hi2 = __builtin_amdgcn_cvt_pk_fp8_f32(sat8(bf_lo(w.z)), sat8(bf_hi(w.z)), hi2, false); hi2 = __builtin_amdgcn_cvt_pk_fp8_f32(sat8(bf_lo(w.w)), sat8(bf_hi(w.w)), hi2, true);
    q8[d0 >> 2][(d0 & 3) * 2] = lo; q8[d0 >> 2][(d0 & 3) * 2 + 1] = hi2; }
}
__device__ __forceinline__ void q_norm_rope(bf16x8 (&qr)[8], const float* __restrict__ gq, float qsc, int t, int hi) {
  float ss = 0.f;
#pragma unroll
  for (int d0 = 0; d0 < 8; ++d0) { const u32x4 w = *reinterpret_cast<const u32x4*>(&qr[d0]);
    ss += (bf_lo(w.x) * bf_lo(w.x) + bf_hi(w.x) * bf_hi(w.x)) + (bf_lo(w.y) * bf_lo(w.y) + bf_hi(w.y) * bf_hi(w.y)) + (bf_lo(w.z) * bf_lo(w.z) + bf_hi(w.z) * bf_hi(w.z)) + (bf_lo(w.w) * bf_lo(w.w) + bf_hi(w.w) * bf_hi(w.w)); }
  { auto rr = __builtin_amdgcn_permlane32_swap(__float_as_uint(ss), __float_as_uint(ss), false, false); ss = __uint_as_float(rr[0]) + __uint_as_float(rr[1]); }
  const float rs = qsc / sqrtf(ss * (1.0f / 128.0f) + 1e-6f);
#pragma unroll
  for (int d0 = 0; d0 < 8; ++d0) {
    const float pos = (float)((d0 < 4) ? (t >> 6) : (t & 63));
    const u32x4 w = *reinterpret_cast<const u32x4*>(&qr[d0]); const unsigned wi[4] = {w.x, w.y, w.z, w.w}; unsigned wo[4];
    const f32x4 ga = *(const f32x4*)(gq + d0 * 16 + hi * 8), gb = *(const f32x4*)(gq + d0 * 16 + hi * 8 + 4); const float g[8] = {ga[0], ga[1], ga[2], ga[3], gb[0], gb[1], gb[2], gb[3]};
#pragma unroll
    for (int jj = 0; jj < 4; ++jj) {
      const float inv = __builtin_amdgcn_exp2f(-(float)(8 * (d0 & 3) + 4 * hi + jj) * (13.287712379549449f / 32.0f)) * 0.15915494309189535f;
      const float rev = pos * inv, fr_ = rev - floorf(rev), cs = __builtin_amdgcn_cosf(fr_), sn = __builtin_amdgcn_sinf(fr_);
      const float y1 = bf_lo(wi[jj]) * rs * g[2 * jj], y2 = bf_hi(wi[jj]) * rs * g[2 * jj + 1];
      wo[jj] = cvt_pk_bf16(y1 * cs - y2 * sn, y1 * sn + y2 * cs);
    }
    const u32x4 o = {wo[0], wo[1], wo[2], wo[3]}; qr[d0] = *reinterpret_cast<const bf16x8*>(&o);
    __builtin_amdgcn_sched_barrier(0);
  }
}
__device__ __forceinline__ void attn_dense_body8(const bf16_t* __restrict__ Qb, const unsigned char* __restrict__ Kh, const unsigned char* __restrict__ Vt,
                                                bf16_t* __restrict__ Ob, int seq, char* lds, LAS unsigned char* ldsl, const float* __restrict__ gq, float qsc, int t0) {
  const int tid = threadIdx.x, wid = __builtin_amdgcn_readfirstlane(tid >> 6), lane = tid & 63, r32 = lane & 31, hi = lane >> 5;
  char* V_lds = lds; char* K_lds = lds + 65536;

  f32x16 o[4] = {}; f32x16 cinit = {}; f32x16 lsum = {}; bf16x8 qr[8];
  i32x8 ones8 = {0x38383838, 0x38383838, 0x38383838, 0x38383838, 0x38383838, 0x38383838, 0x38383838, 0x38383838}; asm volatile("" : "+v"(ones8));
  const bf16_t* Qw = Qb + (long)(wid * QBLK + r32) * LDQ + hi * 8;
#pragma unroll
  for (int d0 = 0; d0 < 8; ++d0) qr[d0] = __builtin_nontemporal_load(reinterpret_cast<const bf16x8*>(Qw + d0 * 16));
  { int tq = t0 + wid * QBLK + r32; asm volatile("" : "+v"(tq) :: "memory");
    int hq = hi; asm volatile("" : "+v"(hq));
    __builtin_amdgcn_sched_barrier(0); q_norm_rope(qr, gq, qsc, tq, hq); __builtin_amdgcn_sched_barrier(0); }
  i32x8 q8[2]; q_to_fp8(qr, q8);
  int tk = tid; asm volatile("" : "+v"(tk));
  const unsigned klo = (unsigned)((tk >> 3) * LDK + (((tk & 7) ^ ((tk >> 4) & 7)) << 4)); const unsigned char* kgl = Kh;
  const unsigned vlo = (unsigned)((tk >> 2) * 64 + (((tk & 3) ^ ((tk >> 4) & 3)) << 4)); const unsigned char* vgl = Vt;
#define DMA(t) do { LAS unsigned char* _st = ldsl + ((t) & 7) * 8192 + wid * 1024; \
    __builtin_amdgcn_global_load_lds((const unsigned*)(vgl + (size_t)(t) * 16384 + (size_t)vlo), (LAS unsigned*)_st, 16, 0, 0); \
    __builtin_amdgcn_global_load_lds((const unsigned*)(kgl + (long)(t) * (KVBLK * LDK) + (size_t)klo), (LAS unsigned*)(_st + 65536), 16, 0, 0); } while (0)
#define TILE_BAR(more) do { if (more) asm volatile("s_waitcnt vmcnt(6)" ::: "memory"); else asm volatile("s_waitcnt vmcnt(0)" ::: "memory"); asm volatile("s_waitcnt lgkmcnt(0)" ::: "memory"); __builtin_amdgcn_s_barrier(); asm volatile("" ::: "memory"); } while (0)
#define RESC1(a) do { for (int r = 0; r < 16; ++r) { lsum[r] *= (a); for (int d = 0; d < 4; ++d) o[d][r] *= (a); } } while (0)
#define RESC(a) do { if (__any((a) < 1.f)) { for (int r = 0; r < 16; ++r) { lsum[r] *= (a); for (int d = 0; d < 4; ++d) o[d][r] *= (a); } } } while (0)
#define HALFS(t, STG, X0, X1, alX, Y0, Y1, alY, BAR) do { \
    SBAR(); \
    { bool _q; const float _pm = tile_step<(STG) * 8192, (((STG) + 7) & 7) * 8192>(X0, X1, Y0, Y1, pa, o, lsum, ones8, lds, ko, vo, q8, cinit, \
          (t) + 5 < NT, vgl, (size_t)((t) + 5) * 16384, vlo, kgl, (long)((t) + 5) * (KVBLK * LDK), klo, ldsl + (((t) + 5) & 7) * 8192 + wid * 1024, _q); \
      if (__builtin_expect(!_q, 0)) { decideSM8(_pm, false, X0, X1, cinit, alX); RESC1(alX); } } \
    if (BAR) TILE_BAR((t) + 5 < NT); } while (0)
  f32x16 pA0, pA1, pB0, pB1; float alA, alB; i32x8 pa = {}; const int NT = seq / KVBLK;
  int ko[4], vo[2];
#pragma unroll
  for (int c = 0; c < 2; ++c)
#pragma unroll
    for (int h = 0; h < 2; ++h) ko[2 * c + h] = 65536 + KSWZ8(r32, 64 * c + 32 * hi + 16 * h);
  vo[0] = VSWZ8(r32, 2 * hi); vo[1] = VSWZ8(r32, 2 * hi + 1);
  DMA(0); DMA(1); DMA(2); DMA(3); DMA(4);
  TILE_BAR(true);
  DMA(5); SBAR();
  qkt8o<0>(pA0, pA1, lds, ko, q8, cinit); partialSM8(pA0, pA1, cinit, alA, true);
  TILE_BAR(true);
#define OCT(tb, LAST7) do { \
    HALFS((tb) + 0, 1, pB0, pB1, alB, pA0, pA1, alA, false); \
    HALFS((tb) + 1, 2, pA0, pA1, alA, pB0, pB1, alB, true); \
    HALFS((tb) + 2, 3, pB0, pB1, alB, pA0, pA1, alA, false); \
    HALFS((tb) + 3, 4, pA0, pA1, alA, pB0, pB1, alB, true); \
    HALFS((tb) + 4, 5, pB0, pB1, alB, pA0, pA1, alA, false); \
    HALFS((tb) + 5, 6, pA0, pA1, alA, pB0, pB1, alB, true); \
    HALFS((tb) + 6, 7, pB0, pB1, alB, pA0, pA1, alA, false); \
    if (!(LAST7)) HALFS((tb) + 7, 0, pA0, pA1, alA, pB0, pB1, alB, true); } while (0)
  int tb = 1;
  for (; tb + 8 < NT; tb += 8) OCT(tb, false);
  OCT(tb, true);
  finishSM8(pB0, pB1, pa); SBAR();
  pv8o<7 * 8192>(o, lsum, ones8, lds, vo, pa);
  const float rl = __builtin_amdgcn_rcpf(lsum[0]);
  int hi_e = hi, r32_e = r32; asm volatile("" : "+v"(hi_e), "+v"(r32_e));
  char* Ow = (char*)(Ob + (long)(wid * QBLK + r32_e) * LDO) + hi_e * 16;
#pragma unroll
  for (int d0 = 0; d0 < 4; ++d0)
#pragma unroll
    for (int gp = 0; gp < 2; ++gp) {
      const int i0 = 8 * gp;
      unsigned ax = cvt_pk_bf16(o[d0][i0 + 0] * rl, o[d0][i0 + 1] * rl), ay = cvt_pk_bf16(o[d0][i0 + 2] * rl, o[d0][i0 + 3] * rl);
      unsigned bx = cvt_pk_bf16(o[d0][i0 + 4] * rl, o[d0][i0 + 5] * rl), by = cvt_pk_bf16(o[d0][i0 + 6] * rl, o[d0][i0 + 7] * rl);
      { auto r = __builtin_amdgcn_permlane32_swap(ax, bx, false, false); ax = r[0]; bx = r[1]; }
      { auto r = __builtin_amdgcn_permlane32_swap(ay, by, false, false); ay = r[0]; by = r[1]; }
      u32x4 w = {ax, ay, bx, by};
      *(u32x4*)(Ow + (d0 * 4 + gp * 2) * 16) = w; }
  __syncthreads();
#undef DMA
#undef TILE_BAR
#undef RESC
#undef HALFS
#undef OCT
}
}

struct Frame {
    LAS unsigned char* lds; char* ldsg;
    int tid, lane, wave, vcu, G;
    unsigned char* ws;
};
struct Args { const float* in[18]; float* out; unsigned char* ws; int ph_lo, ph_hi; };

__device__ __forceinline__ void p0_transpose_item(const float* W, int N, int ncols, bf16_t* WT, int ldt, int col_off, const float* kscale, LAS float* scr, int item, int lane) {
    const int nblk = ncols / 32, kb = item / nblk, nb = item % nblk, k0 = 64 * kb, n0 = 32 * nb;
#pragma unroll 8
    for (int i = 0; i < 32; ++i) { const int kk = 2 * i + (lane >> 5); float w = __builtin_nontemporal_load(&W[(size_t)(k0 + kk) * N + n0 + (lane & 31)]); if (kscale) w *= kscale[k0 + kk]; scr[kk * 33 + (lane & 31)] = w; }
    asm volatile("s_waitcnt lgkmcnt(0)" ::: "memory");
    const int c = lane & 7;
#pragma unroll
    for (int j = 0; j < 4; ++j) { const int n = (lane >> 3) + 8 * j; const LAS float* s = scr + (8 * c) * 33 + n;
        u32x4 o; o.x = cvt_pk_bf16(s[0 * 33], s[1 * 33]); o.y = cvt_pk_bf16(s[2 * 33], s[3 * 33]); o.z = cvt_pk_bf16(s[4 * 33], s[5 * 33]); o.w = cvt_pk_bf16(s[6 * 33], s[7 * 33]);
        *(u32x4*)(WT + (size_t)(n0 + n) * ldt + col_off + k0 + 8 * c) = o; }
    asm volatile("s_waitcnt lgkmcnt(0)" ::: "memory");
}
__device__ __forceinline__ void p0_quant_w_in(const float* w_in, const float* norm_mix, unsigned char* w8, float* sw, LAS unsigned char* lds, int tid, int grp) {
    LAS float* red = (LAS float*)lds;
    LAS unsigned char* tile = lds + 4096;
    const int nn = tid & 31, kk = tid >> 5, n = grp * 30 + (nn < 30 ? nn : 29);
    float mx = 0.f;
    for (int j0 = 0; j0 < 128; j0 += 16) {
        float v[16];
#pragma unroll
        for (int j = 0; j < 16; ++j) { const int k = kk + 16 * (j0 + j); v[j] = w_in[(size_t)k * NIN + n] * norm_mix[k]; }
#pragma unroll
        for (int j = 0; j < 16; ++j) mx = fmaxf(mx, fabsf(v[j]));
    }
    red[kk * 32 + nn] = mx;
    __syncthreads();
    mx = 0.f;
#pragma unroll
    for (int i = 0; i < 16; ++i) mx = fmaxf(mx, red[i * 32 + nn]);
    const float inv = mx > 0.f ? 440.0f / mx : 1.0f;
    if (kk == 0 && nn < 30) sw[grp * 30 + nn] = mx > 0.f ? mx * (1.0f / 440.0f) : 1.0f;
    for (int j0 = 0; j0 < 128; j0 += 16) {
        float v[16];
#pragma unroll
        for (int j = 0; j < 16; ++j) { const int k = kk + 16 * (j0 + j); v[j] = w_in[(size_t)k * NIN + n] * norm_mix[k]; }
        if (nn < 30) {
#pragma unroll
            for (int j = 0; j < 16; j += 2) { int pk = 0; pk = __builtin_amdgcn_cvt_pk_fp8_f32(v[j] * inv, v[j + 1] * inv, pk, false);
                tile[nn * 2064 + kk + 16 * (j0 + j)] = (unsigned char)(pk & 0xff); tile[nn * 2064 + kk + 16 * (j0 + j + 1)] = (unsigned char)((pk >> 8) & 0xff); }
        }
    }
    __syncthreads();
    for (int ch = tid; ch < 30 * 128; ch += 512) { const int r = ch >> 7, cc = (ch & 127) * 16;
        *(u32x4*)(w8 + (size_t)(grp * 30 + r) * DM + cc) = *(const LAS u32x4*)(tile + r * 2064 + cc); }
    __syncthreads();
}
__device__ __forceinline__ void cvt_flat(const float* src, bf16_t* dst, size_t n8, const float* colscale, size_t gtid, size_t gthreads) {
    for (size_t i = gtid; i < n8; i += gthreads) {
        f32x4 a = *(const f32x4*)(src + i * 8), b = *(const f32x4*)(src + i * 8 + 4);
        if (colscale) { const int c = (int)((i * 8) & (DM - 1)); a = a * *(const f32x4*)(colscale + c); b = b * *(const f32x4*)(colscale + c + 4); }
        u32x4 w; w.x = cvt_pk_bf16(a[0], a[1]); w.y = cvt_pk_bf16(a[2], a[3]); w.z = cvt_pk_bf16(b[0], b[1]); w.w = cvt_pk_bf16(b[2], b[3]);
        *(u32x4*)(dst + i * 8) = w;
    }
}

__device__ __forceinline__ void quant_rows_fp8(const float* src, unsigned char* dst, float* scales, const float* colscale, int gw, int ngw, int lane, int row_lo, int row_hi) {
    for (int row = row_lo + gw; row < row_hi; row += ngw) {
        const f32x4* xr = (const f32x4*)(src + (size_t)row * DM) + lane; f32x4 v[8]; float mx = 0.f;
#pragma unroll
        for (int j = 0; j < 8; ++j) { v[j] = __builtin_nontemporal_load(xr + 64 * j); if (colscale) v[j] = v[j] * *((const f32x4*)colscale + lane + 64 * j);
            mx = fmaxf(mx, fmaxf(fmaxf(fabsf(v[j].x), fabsf(v[j].y)), fmaxf(fabsf(v[j].z), fabsf(v[j].w)))); }
#pragma unroll
        for (int o = 1; o < 64; o <<= 1) mx = fmaxf(mx, __shfl_xor(mx, o));
        const float sc = mx > 0.f ? mx * (1.0f / 440.0f) : 1.0f, inv = mx > 0.f ? 440.0f / mx : 1.0f;
        if (lane == 0) scales[row] = sc;
#pragma unroll
        for (int j = 0; j < 8; ++j) { int pk = 0; pk = __builtin_amdgcn_cvt_pk_fp8_f32(v[j].x * inv, v[j].y * inv, pk, false); pk = __builtin_amdgcn_cvt_pk_fp8_f32(v[j].z * inv, v[j].w * inv, pk, true);
            const int col = 4 * lane + 256 * j;
            *(int*)(dst + ((size_t)(col >> 7) * 16384 + row) * 128 + (col & 127)) = pk; }
    }
}

__device__ __forceinline__ int f2key(float f, unsigned payload, unsigned mask) { unsigned b = (__float_as_uint(f) & ~mask) | payload; return (int)(b ^ ((unsigned)((int)b >> 31) & 0x7fffffffu)); }
__device__ __forceinline__ unsigned key2bits(int k) { const unsigned b = (unsigned)k; return b ^ ((unsigned)(k >> 31) & 0x7fffffffu); }
template <int N> __device__ __forceinline__ void bitonic_sort_desc(int (&v)[N]) {
#pragma unroll
    for (int k = 2; k <= N; k <<= 1)
#pragma unroll
        for (int j = k >> 1; j > 0; j >>= 1)
#pragma unroll
            for (int i = 0; i < N; ++i) { const int l = i ^ j; if (l > i) { const int a = v[i], b = v[l]; const int mx = a > b ? a : b, mn = a > b ? b : a; if ((i & k) == 0) { v[i] = mx; v[l] = mn; } else { v[i] = mn; v[l] = mx; } } }
}
template <int N> __device__ __forceinline__ void bitonic_merge_desc(int (&v)[N]) {
#pragma unroll
    for (int j = N >> 1; j > 0; j >>= 1)
#pragma unroll
        for (int i = 0; i < N; ++i) { const int l = i ^ j; if (l > i) { const int a = v[i], b = v[l]; v[i] = a > b ? a : b; v[l] = a > b ? b : a; } }
}
__device__ __forceinline__ void top16_merge(int (&a)[16], const int (&b)[16]) {
#pragma unroll
    for (int i = 0; i < 16; ++i) a[i] = a[i] > b[15 - i] ? a[i] : b[15 - i];
    bitonic_merge_desc<16>(a);
}
__device__ __forceinline__ void top16_of_128(const f32x16 (&p)[4], int hi, int (&res)[16]) {
    int g[4][16];
#pragma unroll
    for (int mt = 0; mt < 4; ++mt) {
#pragma unroll
        for (int r = 0; r < 16; ++r) g[mt][r] = f2key(p[mt][r], (unsigned)(mt * 32 + att::crow(r, hi)), 127u);
        bitonic_sort_desc<16>(g[mt]);
    }
    top16_merge(g[0], g[1]); top16_merge(g[2], g[3]); top16_merge(g[0], g[2]);
    int o[16];
#pragma unroll
    for (int i = 0; i < 16; ++i) o[i] = __shfl_xor(g[0][i], 32);
    top16_merge(g[0], o);
#pragma unroll
    for (int i = 0; i < 16; ++i) res[i] = g[0][i];
}

#define CAND_LIST(X) X(0,0,0) X(1,0,1) X(2,0,2) X(3,0,3) X(4,0,4) X(5,0,5) X(6,0,6) X(7,0,7) X(8,0,8) X(9,0,9) X(10,0,10) X(11,0,11) X(12,0,12) X(13,0,13) X(14,0,14) X(15,0,15) \
    X(16,1,0) X(17,1,1) X(18,1,2) X(19,1,3) X(20,1,4) X(21,1,5) X(22,1,6) X(23,1,7) X(24,2,0) X(25,2,1) X(26,2,2) X(27,2,3) X(28,2,4) X(29,3,0) X(30,3,1) X(31,3,2) X(32,3,3) \
    X(33,4,0) X(34,4,1) X(35,4,2) X(36,5,0) X(37,5,1) X(38,6,0) X(39,6,1) X(40,7,0) X(41,7,1) X(42,8,0) X(43,9,0) X(44,10,0) X(45,11,0) X(46,12,0) X(47,13,0) X(48,14,0) X(49,15,0)

__global__ void __launch_bounds__(512, 2) fwd_kernel(Args args) {
    extern __shared__ __attribute__((aligned(16))) unsigned char lds_raw[];
    Frame F;
    F.lds = (LAS unsigned char*)lds_raw; F.ldsg = (char*)lds_raw;
    F.tid = threadIdx.x; F.lane = F.tid & 63; F.wave = __builtin_amdgcn_readfirstlane(F.tid >> 6);
    F.G = gridDim.x; { const int bx = blockIdx.x; F.vcu = (F.G % 8 == 0) ? (bx % 8) * (F.G / 8) + bx / 8 : bx; }
    F.ws = args.ws;
    unsigned char* ws = args.ws;
    const int lo = args.ph_lo, hi_ph = args.ph_hi;
    volatile LAS unsigned* MISC = (volatile LAS unsigned*)(F.lds + MISC_OFF);
    if (F.tid < 4) MISC[F.tid] = 0u;
    __syncthreads();
    XcdBarrier bar; bar.bar = (unsigned*)(ws + WS_CTL) + CW_BAR; bar.x = 0; bar.st = nullptr;
    if (MK_N_LAUNCHES == 1) bar = xcd_barrier_post((unsigned*)(ws + WS_CTL) + CW_BAR, MISC);
#define IN(k) (lo <= (k) && (k) < hi_ph)
#define PH_ON(k) ((PHASE_MASK >> (k)) & 1)
#define SEAM(k) do { if (IN(k) && IN((k) + 1)) xcd_barrier(bar); } while (0)
#define OPQ_TID() ({ int t_ = threadIdx.x; asm volatile("" : "+v"(t_)); t_; })
    const int gw = F.vcu * 8 + F.wave, NGW = F.G * 8;
    const size_t gtid = (size_t)blockIdx.x * 512 + F.tid, gthreads = (size_t)F.G * 512;

    const float* x = args.in[0]; const float* norm_mix = args.in[1]; const float* w_in = args.in[2]; const float* b_gate = args.in[3];
    const float* q_norm = args.in[4]; const float* k_norm = args.in[5]; const float* sgu_norm = args.in[6]; const float* w_sgu = args.in[7]; const float* b_sgu = args.in[8];
    const float* w_attn_proj = args.in[9]; const float* w_sgu_proj = args.in[10]; const float* w_out = args.in[11]; const float* norm_ffn = args.in[12];
    const float* w_peer_q = args.in[13]; const float* peer_k1 = args.in[14]; const float* peer_k2 = args.in[15]; const float* peer_u = args.in[16]; const float* peer_v = args.in[17];
    float* out = args.out;
    float* rsx = (float*)(ws + WS_RSX); float* swg = (float*)(ws + WS_SWG); unsigned char* x8 = ws + WS_X8; unsigned char* wg8 = ws + WS_WG8;
    float* ssqv = (float*)(ws + WS_SSQV); float* ssq2 = (float*)(ws + WS_SSQ2);
    bf16_t* k1b = (bf16_t*)(ws + WS_K1); bf16_t* k2b = (bf16_t*)(ws + WS_K2); bf16_t* wsgub = (bf16_t*)(ws + WS_WSGU);
    bf16_t* pcat = (bf16_t*)(ws + WS_PCAT); bf16_t* woutT = (bf16_t*)(ws + WS_WOUT); bf16_t* wpqT = (bf16_t*)(ws + WS_WPQ);
    bf16_t* merged = (bf16_t*)(ws + WS_B);
    int* eidx = (int*)(ws + WS_EIDX); float* gatev = (float*)(ws + WS_GATE); float* usu = (float*)(ws + WS_USU);
    unsigned char* vt8 = ws + WS_K + 4 * MiB;
    bf16_t* qb = (bf16_t*)(ws + WS_Q); bf16_t* kb = (bf16_t*)(ws + WS_K); bf16_t* vb = (bf16_t*)(ws + WS_V); bf16_t* gu = (bf16_t*)(ws + WS_GU); bf16_t* gv = (bf16_t*)(ws + WS_GV);
    bf16_t* h1b = (bf16_t*)(ws + WS_D);
    bf16_t* cat = (bf16_t*)(ws + WS_E); bf16_t* qp = (bf16_t*)(ws + WS_E);
    bf16_t* gates = (bf16_t*)(ws + WS_F); unsigned char* utab = ws + WS_UT; unsigned char* vtab = ws + WS_VT; float* su_sc = (float*)(ws + WS_SU); float* sv_sc = (float*)(ws + WS_SV);

    if (PH_ON(0) && IN(0)) {
        LAS float* scr = (LAS float*)(F.lds + F.wave * 16384);
        constexpr int I_PA = (1024 / 64) * (DM / 32), I_SQ = (DM / 64) * (DM / 32);
        constexpr int NITEMS = 2 * I_PA + 2 * I_SQ;
        for (int it = gw; it < NITEMS; it += NGW) {
            int r = it;
            if (r < I_PA) { p0_transpose_item(w_attn_proj, DM, DM, pcat, 2048, 0, nullptr, scr, r, F.lane); continue; } r -= I_PA;
            if (r < I_PA) { p0_transpose_item(w_sgu_proj, DM, DM, pcat, 2048, 1024, nullptr, scr, r, F.lane); continue; } r -= I_PA;
            if (r < I_SQ) { p0_transpose_item(w_out, DM, DM, woutT, DM, 0, nullptr, scr, r, F.lane); continue; } r -= I_SQ;
            p0_transpose_item(w_peer_q, DM, DM, wpqT, DM, 0, norm_ffn, scr, r, F.lane);
        }
        __syncthreads();
        for (int grp = (int)blockIdx.x; grp < NIN / 30; grp += F.G) p0_quant_w_in(w_in, norm_mix, wg8, swg, F.lds, F.tid, grp);
        cvt_flat(peer_k1, k1b, 131072 / 8, nullptr, gtid, gthreads);
        cvt_flat(peer_k2, k2b, 131072 / 8, nullptr, gtid, gthreads);
        cvt_flat(w_sgu, wsgub, 131072 / 8, nullptr, gtid, gthreads);
        for (int m = gw; m < SEQ; m += NGW) {
            const f32x4* xr = (const f32x4*)(x + (size_t)m * DM) + F.lane; f32x4 v[8]; float s = 0.f;
#pragma unroll
            for (int j = 0; j < 8; ++j) { v[j] = __builtin_nontemporal_load(xr + 64 * j); s += (v[j].x * v[j].x + v[j].y * v[j].y) + (v[j].z * v[j].z + v[j].w * v[j].w); }
            s = wave_sum(s);
            float mx = 0.f;
#pragma unroll
            for (int j = 0; j < 8; ++j) mx = fmaxf(mx, fmaxf(fmaxf(fabsf(v[j].x), fabsf(v[j].y)), fmaxf(fabsf(v[j].z), fabsf(v[j].w))));
#pragma unroll
            for (int o = 1; o < 64; o <<= 1) mx = fmaxf(mx, __shfl_xor(mx, o));
            const float rsd = 1.0f / sqrtf(s * (1.0f / DM) + EPS), inv8 = mx > 0.f ? 440.0f / mx : 1.0f;
            if (F.lane == 0) rsx[m] = rsd * (mx > 0.f ? mx * (1.0f / 440.0f) : 1.0f);
            int* o4 = (int*)(x8 + (size_t)m * DM) + F.lane;
#pragma unroll
            for (int j = 0; j < 8; ++j) { int pk = 0; pk = __builtin_amdgcn_cvt_pk_fp8_f32(v[j].x * inv8, v[j].y * inv8, pk, false); pk = __builtin_amdgcn_cvt_pk_fp8_f32(v[j].z * inv8, v[j].w * inv8, pk, true); o4[64 * j] = pk; }
        }
    }
    SEAM(0);

    if (PH_ON(1) && IN(1)) {
        pg8::Gemm g{(const bf16_t*)x8, (const bf16_t*)wg8, DM / 2, DM / 2, DM / 2}; pg8::P1Order S; S.init(SEQ / 256, NIN / 256, F.G, (int)blockIdx.x);
        pg8::Epi1 E{rsx, swg, qb, kb, vb, gu, gv, gates, b_gate, ssqv, k_norm, (LAS float*)(F.lds + RS2_OFF), SELFCHECK ? (bf16_t*)(ws + WS_DBGK) : nullptr, vt8};
        pg8::gemm_phase<pg8::Epi1, pg8::P1Order, true>(F.lds, g, S, E);
        if ((int)blockIdx.x >= 128) { const int l1 = OPQ_TID() & 63, w1 = ((int)blockIdx.x - 128) * 8 + F.wave;
            quant_rows_fp8(peer_u, utab, su_sc, norm_ffn, w1, 1024, l1, 0, QROWS_P1); quant_rows_fp8(peer_v, vtab, sv_sc, nullptr, w1, 1024, l1, 0, QROWS_P1); }
    }
    SEAM(1);


    if (PH_ON(3) && IN(3)) {
        for (int i = 0; i < 2; ++i) {
            const int L = i * 256 + F.vcu; if (L >= 512) break;
            const int h = L >> 6, qblk = L & 63, kvh = h >> 2;
            att::attn_dense_body8(qb + (size_t)(qblk * 256) * QW + h * HD, (const unsigned char*)kb + kvh * HD, vt8 + kvh * 8192, cat + (size_t)(qblk * 256) * 2048 + h * HD, SEQ, F.ldsg, F.lds, q_norm, att::SCALE * 1.4426950408889634f, qblk * 256);
        }
        int tidS = threadIdx.x; asm volatile("" : "+v"(tidS));
        const int laneS = tidS & 63;
        LAS bf16_t* vnT = (LAS bf16_t*)F.lds;
        LAS float* rsq = (LAS float*)(F.lds + 128 * 136 * 2);
        for (int s = F.vcu; s < 1024; s += 256) {
            const int c = s >> 3, g = s & 7;
            if (tidS < 128) { const f32x4* pp = (const f32x4*)(ssqv + (size_t)(c * 128 + tidS) * 16); const f32x4 a = pp[0], b = pp[1], cc = pp[2], d = pp[3];
                const float tot = ((a.x + a.y) + (a.z + a.w)) + ((b.x + b.y) + (b.z + b.w)) + ((cc.x + cc.y) + (cc.z + cc.w)) + ((d.x + d.y) + (d.z + d.w));
                rsq[tidS] = 1.0f / sqrtf(tot * (1.0f / SGW) + EPS); }
            __syncthreads();
#pragma unroll
            for (int pss = 0; pss < 4; ++pss) {
                const int ch = pss * 512 + tidS, qq = ch >> 4, d0 = (ch & 15) * 8;
                const u32x4 w = __builtin_nontemporal_load((const u32x4*)(gv + (size_t)(c * 128 + qq) * SGW + g * 128 + d0));
                const float rs = rsq[qq]; const f32x4 n0 = *(const f32x4*)(sgu_norm + g * 128 + d0), n1 = *(const f32x4*)(sgu_norm + g * 128 + d0 + 4);
                float e[8] = {bf_lo(w.x) * rs * n0.x, bf_hi(w.x) * rs * n0.y, bf_lo(w.y) * rs * n0.z, bf_hi(w.y) * rs * n0.w, bf_lo(w.z) * rs * n1.x, bf_hi(w.z) * rs * n1.y, bf_lo(w.w) * rs * n1.z, bf_hi(w.w) * rs * n1.w};
#pragma unroll
                for (int j = 0; j < 8; ++j) vnT[(d0 + j) * 136 + qq] = (bf16_t)(cvt_pk_bf16(e[j], e[j]) & 0xffffu);
            }
            __syncthreads();
            {
                const int fr = laneS & 15, fq = laneS >> 4, w = F.wave;
                bf16x8 af[4];
#pragma unroll
                for (int ks = 0; ks < 4; ++ks) af[ks] = *(const bf16x8*)(wsgub + (size_t)g * 16384 + (size_t)(16 * w + fr) * 128 + ks * 32 + fq * 8);
                f32x4 acc[8];
#pragma unroll
                for (int n = 0; n < 8; ++n) { acc[n] = (f32x4){0.f, 0.f, 0.f, 0.f};
#pragma unroll
                    for (int ks = 0; ks < 4; ++ks) { const bf16x8 bfrag = *(const LAS bf16x8*)(vnT + (16 * n + fr) * 136 + ks * 32 + fq * 8);
                        acc[n] = __builtin_amdgcn_mfma_f32_16x16x32_bf16(bfrag, af[ks], acc[n], 0, 0, 0); } }
                const int p = 16 * w + fr; const float bb = b_sgu[g * 128 + p];
                const size_t rowoff = (size_t)(c * 128 + p);
#pragma unroll
                for (int n = 0; n < 8; ++n) { const int d = 16 * n + 4 * fq;
                    const u32x2 uw = __builtin_nontemporal_load((const u32x2*)(gu + rowoff * SGW + g * 128 + d));
                    const float o0 = bf_lo(uw.x) * (acc[n][0] + bb), o1 = bf_hi(uw.x) * (acc[n][1] + bb), o2 = bf_lo(uw.y) * (acc[n][2] + bb), o3 = bf_hi(uw.y) * (acc[n][3] + bb);
                    u32x2 ow; ow.x = cvt_pk_bf16(o0, o1); ow.y = cvt_pk_bf16(o2, o3);
                    *(u32x2*)(cat + rowoff * 2048 + 1024 + g * 128 + d) = ow; }
            }
            __syncthreads();
        }
    }
    SEAM(3);

#if SELFCHECK
    if (IN(4) && gw < 64) {
        const int l = OPQ_TID() & 63; const int t = (int)((((unsigned)gw * 2654435761u) >> 9) & 16383u), h = gw & 7, kvh = h >> 2;
        LAS float* qs = (LAS float*)(F.lds) + F.wave * 128;
        float* sc = (float*)(ws + WS_DBGS) + (size_t)gw * 16384;
        const bf16_t* dq = qb; const bf16_t* dk = (const bf16_t*)(ws + WS_DBGK);
        {
            const float x1 = __uint_as_float((unsigned)dq[(size_t)t * 1024 + h * 128 + 2 * l] << 16), x2 = __uint_as_float((unsigned)dq[(size_t)t * 1024 + h * 128 + 2 * l + 1] << 16);
            const float rs = 1.0f / sqrtf(wave_sum(x1 * x1 + x2 * x2) / 128.0f + 1e-6f);
            const float y1 = x1 * rs * q_norm[2 * l], y2 = x2 * rs * q_norm[2 * l + 1];
            const float pos = (l < 32) ? (float)(t / 64) : (float)(t % 64); const float freq = expf(-(float)(l % 32) / 32.0f * logf(10000.0f));
            const float a = pos * freq, rev = a * 0.15915494309189535f, fr = rev - floorf(rev); const float cs = __builtin_amdgcn_cosf(fr), sn = __builtin_amdgcn_sinf(fr);
            qs[2 * l] = y1 * cs - y2 * sn; qs[2 * l + 1] = y1 * sn + y2 * cs;
        }
        float M = -1e30f, L = 0.f;
        for (int ch = 0; ch < 256; ++ch) {
            const int key = ch * 64 + l; const bf16_t* kr = dk + (size_t)key * 256 + kvh * 128;
            float ss = 0.f;
            for (int i = 0; i < 128; ++i) { const float x = __uint_as_float((unsigned)kr[i] << 16); ss += x * x; }
            const float rs = 1.0f / sqrtf(ss / 128.0f + 1e-6f); float dot = 0.f;
            for (int i = 0; i < 64; ++i) {
                const float y1 = __uint_as_float((unsigned)kr[2 * i] << 16) * rs * k_norm[2 * i], y2 = __uint_as_float((unsigned)kr[2 * i + 1] << 16) * rs * k_norm[2 * i + 1];
                const float pos = (i < 32) ? (float)(key / 64) : (float)(key % 64); const float freq = expf(-(float)(i % 32) / 32.0f * logf(10000.0f));
                const float a = pos * freq, rev = a * 0.15915494309189535f, fr = rev - floorf(rev); const float cs = __builtin_amdgcn_cosf(fr), sn = __builtin_amdgcn_sinf(fr);
                dot += qs[2 * i] * (y1 * cs - y2 * sn) + qs[2 * i + 1] * (y1 * sn + y2 * cs);
            }
            const float sv_ = dot * 0.08838834764831845f; sc[key] = sv_;
            const float Mn = fmaxf(M, sv_); L = L * expf(M - Mn) + expf(sv_ - Mn); M = Mn;
        }
        float Mw = M;
#pragma unroll
        for (int o = 1; o < 64; o <<= 1) Mw = fmaxf(Mw, __shfl_xor(Mw, o));
        const float Lw = wave_sum(L * expf(M - Mw));
        float o1 = 0.f, o2 = 0.f;
        for (int ch = 0; ch < 256; ++ch) {
            const float pk = expf(sc[ch * 64 + l] - Mw) / Lw;
            for (int kk = 0; kk < 64; ++kk) { const float pb = __uint_as_float(__builtin_amdgcn_readlane(__float_as_uint(pk), kk));
                const unsigned vw = *(const unsigned*)(vb + (size_t)(ch * 64 + kk) * 256 + kvh * 128 + 2 * l); o1 += pb * bf_lo(vw); o2 += pb * bf_hi(vw); }
        }
        const unsigned cw = *(const unsigned*)(cat + (size_t)t * 2048 + h * 128 + 2 * l);
        float err = fmaxf(fabsf(o1 - bf_lo(cw)), fabsf(o2 - bf_hi(cw))), ref = fmaxf(fabsf(o1), fabsf(o2));
#pragma unroll
        for (int o = 1; o < 64; o <<= 1) { err = fmaxf(err, __shfl_xor(err, o)); ref = fmaxf(ref, __shfl_xor(ref, o)); }
        if (!(err <= 0.05f * ref + 1e-5f) && l == 0) atomicAdd((unsigned*)(ws + WS_CTL) + CW_CHK, 1u);
    }
    if (IN(3) && IN(4)) xcd_barrier(bar);
#endif
    if (PH_ON(4) && IN(4)) {
        pg8::Gemm g{cat, pcat, 2048, 2048, 2048}; pg8::Order2D S; S.init(SEQ / 256, DM / 256, F.G, (int)blockIdx.x);
        pg8::Epi3 E{ws};
        pg8::gemm_phase<pg8::Epi3, pg8::Order2D>(F.lds, g, S, E);
    }
    SEAM(4);

    if (PH_ON(5) && IN(5)) {
        { const int l5 = OPQ_TID() & 63; quant_rows_fp8(peer_u, utab, su_sc, norm_ffn, gw, NGW, l5, QROWS_P1, 16384); quant_rows_fp8(peer_v, vtab, sv_sc, nullptr, gw, NGW, l5, QROWS_P1, 16384); }
        pg8::Gemm g{merged, woutT, DM, DM, DM}; pg8::Order2D S; S.init(SEQ / 256, DM / 256, F.G, (int)blockIdx.x);
        pg8::Epi4 E{x, out, h1b, ssq2};
        pg8::gemm_phase<pg8::Epi4, pg8::Order2D>(F.lds, g, S, E);
    }
    SEAM(5);

    if (PH_ON(6) && IN(6)) {
        pg8::Order2D S; S.init(SEQ / 256, DM / 256, F.G, (int)blockIdx.x);
        LAS float* rs2 = (LAS float*)(F.lds + RS2_OFF);
        {
            const int t6 = OPQ_TID(); const int ui = t6 >> 8, rl = t6 & 255; pg8::Unit u;
            if (S.next(ui, u)) { const f32x4* pp = (const f32x4*)(ssq2 + (size_t)(u.pm * 256 + rl) * 32); float tot = 0.f;
#pragma unroll
                for (int j = 0; j < 8; ++j) { const f32x4 a = pp[j]; tot += (a.x + a.y) + (a.z + a.w); }
                rs2[ui * 256 + rl] = 1.0f / sqrtf(tot * (1.0f / DM) + EPS); }
        }
        __syncthreads();
        pg8::Gemm g{h1b, wpqT, DM, DM, DM};
        pg8::Epi5 E{rs2, qp};
        pg8::gemm_phase<pg8::Epi5, pg8::Order2D>(F.lds, g, S, E);
        asm volatile("s_waitcnt vmcnt(0)" ::: "memory");
        __syncthreads();
        int tid6 = threadIdx.x; asm volatile("" : "+v"(tid6));
        const int r32 = tid6 & 31, hi = (tid6 >> 5) & 1;
        LAS unsigned* ixs = (LAS unsigned*)(F.lds) + (F.wave * 64 + (tid6 & 63)) * 9;
        for (int ui = 0; ui < 2; ++ui) {
            pg8::Unit u; if (!S.next(ui, u)) break;
            const int head = u.pn, tok = u.pm * 256 + F.wave * 32 + r32;
            const bf16_t* qrow = qp + (size_t)tok * DM + head * 256;
            int v1[16], v2[16];
#pragma unroll
            for (int half = 0; half < 2; ++half) {
                const bf16_t* kk = (half ? k2b : k1b) + (size_t)head * 16384;
                bf16x8 qf[8];
#pragma unroll
                for (int ks = 0; ks < 8; ++ks) qf[ks] = *(const bf16x8*)(qrow + half * 128 + ks * 16 + hi * 8);
                f32x16 p[4];
#pragma unroll
                for (int mt = 0; mt < 4; ++mt) { p[mt] = f32x16{};
#pragma unroll
                    for (int ks = 0; ks < 8; ++ks) { const bf16x8 kf = *(const bf16x8*)(kk + (size_t)(mt * 32 + r32) * 128 + ks * 16 + hi * 8);
                        p[mt] = __builtin_amdgcn_mfma_f32_32x32x16_bf16(kf, qf[ks], p[mt], 0, 0, 0); } }
                if (half == 0) top16_of_128(p, hi, v1); else top16_of_128(p, hi, v2);
            }
            float f1[16], f2[16];
            {
                unsigned pk[8];
#pragma unroll
                for (int i = 0; i < 8; ++i) pk[i] = 0u;
#pragma unroll
                for (int i = 0; i < 16; ++i) { const unsigned b1 = key2bits(v1[i]), b2 = key2bits(v2[i]);
                    f1[i] = __uint_as_float(b1 & ~127u); f2[i] = __uint_as_float(b2 & ~127u);
                    pk[i >> 2] |= (b1 & 127u) << (8 * (i & 3)); pk[4 + (i >> 2)] |= (b2 & 127u) << (8 * (i & 3)); }
#pragma unroll
                for (int i = 0; i < 8; ++i) ixs[i] = pk[i];
            }
            int cg[4][16];
#define X(k, i, j) cg[(k) >> 4][(k) & 15] = f2key(f1[i] + f2[j], (unsigned)((i) * 16 + (j)), 255u);
            CAND_LIST(X)
#undef X
#pragma unroll
            for (int k = 50; k < 64; ++k) cg[k >> 4][k & 15] = (int)0x80000000;
            bitonic_sort_desc<16>(cg[0]); bitonic_sort_desc<16>(cg[1]); bitonic_sort_desc<16>(cg[2]); bitonic_sort_desc<16>(cg[3]);
            top16_merge(cg[0], cg[1]); top16_merge(cg[2], cg[3]); top16_merge(cg[0], cg[2]);
            float cv[16]; unsigned cid[16];
#pragma unroll
            for (int i = 0; i < 16; ++i) { const unsigned b = key2bits(cg[0][i]); cv[i] = __uint_as_float(b & ~255u); cid[i] = b & 255u; }
            float sum = 0.f; float ex[16];
#pragma unroll
            for (int i = 0; i < 16; ++i) { ex[i] = __builtin_amdgcn_exp2f((cv[i] - cv[0]) * 1.4426950408889634f); sum += ex[i]; }
            const float rsum = 1.0f / sum;
            asm volatile("s_waitcnt lgkmcnt(0)" ::: "memory");
            if (hi == 0) {
                int eo[16]; float go[16];
#pragma unroll
                for (int i = 0; i < 16; ++i) { const unsigned ii = cid[i] >> 4, jj = cid[i] & 15u;
                    const unsigned e1 = (ixs[ii >> 2] >> (8 * (ii & 3))) & 127u, e2 = (ixs[4 + (jj >> 2)] >> (8 * (jj & 3))) & 127u;
                    eo[i] = (int)(e1 * 128u + e2); go[i] = ex[i] * rsum; }
                float uo[16];
#pragma unroll
                for (int i = 0; i < 16; ++i) { uo[i] = su_sc[eo[i]]; go[i] *= sv_sc[eo[i]]; }
                int* ep = eidx + (size_t)tok * 128 + head * 16; float* gp = gatev + (size_t)tok * 128 + head * 16; float* up = usu + (size_t)tok * 128 + head * 16;
#pragma unroll
                for (int i = 0; i < 4; ++i) { *(int4*)(ep + 4 * i) = make_int4(eo[4 * i], eo[4 * i + 1], eo[4 * i + 2], eo[4 * i + 3]); *(f32x4*)(gp + 4 * i) = (f32x4){go[4 * i], go[4 * i + 1], go[4 * i + 2], go[4 * i + 3]};
                    *(f32x4*)(up + 4 * i) = (f32x4){uo[4 * i], uo[4 * i + 1], uo[4 * i + 2], uo[4 * i + 3]}; }
            }
            asm volatile("s_waitcnt lgkmcnt(0)" ::: "memory");
        }
    }
    SEAM(6);

    if (PH_ON(7) && IN(7)) {
        int tid7 = threadIdx.x; asm volatile("" : "+v"(tid7));
        const int l = tid7 & 63, p = l >> 3, c = l & 7;
        LAS unsigned* eo = (LAS unsigned*)(F.lds) + F.wave * 3072;
        LAS float* av = (LAS float*)(F.lds) + F.wave * 3072 + 1024;
        LAS float* gs = (LAS float*)(F.lds) + F.wave * 3072 + 2048;
        const int grp = blockIdx.x & 7, ci = blockIdx.x >> 3;
        const unsigned c16 = (unsigned)c * 16u;
        const float poison = (SELFCHECK && __hip_atomic_load((unsigned*)(ws + WS_CTL) + CW_CHK, __ATOMIC_RELAXED, __HIP_MEMORY_SCOPE_AGENT) != 0u) ? __builtin_nanf("") : 0.f;
        typedef __bf16 b2v __attribute__((ext_vector_type(2)));
        {
            const int t0 = grp * 2048 + ci * 64 + F.wave * 8;
#pragma unroll
            for (int tt = 0; tt < 8; ++tt) {
#pragma unroll
                for (int hf = 0; hf < 2; ++hf) { const size_t gi = (size_t)(t0 + tt) * 128 + hf * 64 + l; const int li = tt * 128 + hf * 64 + l;
                    eo[li] = (unsigned)eidx[gi] << 7; av[li] = usu[gi]; gs[li] = gatev[gi]; } }
            float acc[8][16];
#pragma unroll
            for (int tt = 0; tt < 8; ++tt)
#pragma unroll
                for (int r = 0; r < 16; ++r) acc[tt][r] = 0.f;
            for (int sl = 0; sl < 16; ++sl) {
                asm volatile("" ::: "memory");
                const unsigned char* ub = utab + (size_t)sl * (2u << 20);
#pragma unroll
                for (int tt = 0; tt < 8; ++tt) {
                    const u32x4* xp = (const u32x4*)((const char*)h1b + (size_t)(t0 + tt) * 4096 + sl * 256 + c * 32);
                    const u32x4 xs0 = xp[0], xs1 = xp[1];
                    const unsigned xs[8] = {xs0.x, xs0.y, xs0.z, xs0.w, xs1.x, xs1.y, xs1.z, xs1.w};
                    u32x4 w[16];
#pragma unroll
                    for (int r = 0; r < 16; ++r) { const unsigned vo = eo[tt * 128 + r * 8 + p] | c16; w[r] = *(const u32x4*)(ub + vo); }
#pragma unroll
                    for (int r = 0; r < 16; ++r) { float a = acc[tt][r];
#pragma unroll
                        for (int j = 0; j < 4; ++j) { const unsigned dw = w[r][j];
                            a = __builtin_amdgcn_fdot2_f32_bf16(__builtin_amdgcn_cvt_scalef32_pk_bf16_fp8(dw, 1.0f, false), __builtin_bit_cast(b2v, xs[2 * j]), a, false);
                            a = __builtin_amdgcn_fdot2_f32_bf16(__builtin_amdgcn_cvt_scalef32_pk_bf16_fp8(dw, 1.0f, true), __builtin_bit_cast(b2v, xs[2 * j + 1]), a, false); }
                        acc[tt][r] = a; __builtin_amdgcn_sched_barrier(0); }
                    __builtin_amdgcn_sched_barrier(0);
                }
            }
#pragma unroll
            for (int tt = 0; tt < 8; ++tt) {
                float tot = (l < 32) ? ssq2[(size_t)(t0 + tt) * 32 + l] : 0.f; tot = wave_sum(tot);
                const float rs2v = 1.0f / sqrtf(tot * (1.0f / DM) + EPS);
#pragma unroll
                for (int r = 0; r < 16; ++r) { float a = acc[tt][r]; a += __shfl_xor(a, 1); a += __shfl_xor(a, 2); a += __shfl_xor(a, 4);
                    const int li = tt * 128 + r * 8 + p;
                    av[li] = gelu_tanh(a * rs2v * av[li]) * gs[li]; }
                __builtin_amdgcn_sched_barrier(0);
            }
            for (int sl = 0; sl < 16; ++sl) {
                asm volatile("" ::: "memory");
                const unsigned char* vbp = vtab + (size_t)sl * (2u << 20);
#pragma unroll
                for (int tt = 0; tt < 8; ++tt) {
                    u32x4 w[16];
#pragma unroll
                    for (int r = 0; r < 16; ++r) { const unsigned vo = eo[tt * 128 + r * 8 + p] | c16; w[r] = *(const u32x4*)(vbp + vo); }
                    float o16[16];
#pragma unroll
                    for (int i = 0; i < 16; ++i) o16[i] = 0.f;
#pragma unroll
                    for (int r = 0; r < 16; ++r) { const float a = av[tt * 128 + r * 8 + p];
#pragma unroll
                        for (int j = 0; j < 4; ++j) { const unsigned dw = w[r][j]; const f32x2 lo2 = __builtin_amdgcn_cvt_pk_f32_fp8(dw, false), hi2 = __builtin_amdgcn_cvt_pk_f32_fp8(dw, true);
                            o16[4 * j + 0] += a * lo2.x; o16[4 * j + 1] += a * lo2.y; o16[4 * j + 2] += a * hi2.x; o16[4 * j + 3] += a * hi2.y; }
                        __builtin_amdgcn_sched_barrier(0); }
                    const bool b0 = (p & 1) != 0, b1 = (p & 2) != 0, b2 = (p & 4) != 0;
                    float n8[8], n4[4], n2[2];
#pragma unroll
                    for (int i = 0; i < 8; ++i) { const float keep = b0 ? o16[8 + i] : o16[i], send = b0 ? o16[i] : o16[8 + i]; n8[i] = keep + __shfl_xor(send, 8); }
#pragma unroll
                    for (int i = 0; i < 4; ++i) { const float keep = b1 ? n8[4 + i] : n8[i], send = b1 ? n8[i] : n8[4 + i]; n4[i] = keep + __shfl_xor(send, 16); }
#pragma unroll
                    for (int i = 0; i < 2; ++i) { const float keep = b2 ? n4[2 + i] : n4[i], send = b2 ? n4[i] : n4[2 + i]; n2[i] = keep + __shfl_xor(send, 32); }
                    f32x2* op = (f32x2*)(out + (size_t)(t0 + tt) * DM + sl * 128 + c * 16 + ((p & 1) * 8 + ((p >> 1) & 1) * 4 + ((p >> 2) & 1) * 2));
                    const unsigned hw = *(const unsigned*)(h1b + (size_t)(t0 + tt) * DM + sl * 128 + c * 16 + ((p & 1) * 8 + ((p >> 1) & 1) * 4 + ((p >> 2) & 1) * 2));
                    f32x2 hv; hv.x = bf_lo(hw) + n2[0] + poison; hv.y = bf_hi(hw) + n2[1] + poison; __builtin_nontemporal_store(hv, op);
                    __builtin_amdgcn_sched_barrier(0);
                }
            }
        }
    }
#undef IN
#undef SEAM
}

extern "C" void kernel_launch(void* const* d_in, const int* in_sizes, int n_in, void* d_out, int out_size, void* d_ws, size_t ws_size, hipStream_t stream) {
    static int grid = 0;
    if (grid == 0) {
        if (n_in != 18 || in_sizes[0] != SEQ * DM || out_size != SEQ * DM || ws_size < WS_END) {
            fprintf(stderr, "kernel_launch: shape mismatch (n_in %d, in0 %d, out %d, ws %zu; need ws >= %zu)\n", n_in, n_in > 0 ? in_sizes[0] : -1, out_size, ws_size, (size_t)WS_END); grid = -1; return; }
        int dev = 0, cus = 0, per_cu = 0;
        if (hipGetDevice(&dev) != hipSuccess || hipDeviceGetAttribute(&cus, hipDeviceAttributeMultiprocessorCount, dev) != hipSuccess) { grid = -1; return; }
        if (hipFuncSetAttribute((const void*)fwd_kernel, hipFuncAttributeMaxDynamicSharedMemorySize, LDS_BYTES) != hipSuccess) { fprintf(stderr, "kernel_launch: hipFuncSetAttribute failed\n"); grid = -1; return; }
        if (hipOccupancyMaxActiveBlocksPerMultiprocessor(&per_cu, (const void*)fwd_kernel, 512, LDS_BYTES) != hipSuccess || per_cu < 1) { fprintf(stderr, "kernel_launch: occupancy query says %d blocks per CU\n", per_cu); grid = -1; return; }
        (void)hipGetLastError();
        grid = cus;
        if (grid != 256) { fprintf(stderr, "kernel_launch: expected 256 CUs, got %d\n", grid); grid = -1; return; }
    }
    if (grid < 0) return;
    (void)hipMemsetAsync((char*)d_ws + WS_CTL, 0, CTL_ZERO_BYTES, stream);
    Args a{};
    for (int i = 0; i < 18; ++i) a.in[i] = (const float*)d_in[i];
    a.out = (float*)d_out; a.ws = (unsigned char*)d_ws;
    if (PROBE_SPLIT >= 0) { a.ph_lo = 0; a.ph_hi = PROBE_SPLIT + 1; hipLaunchKernelGGL(fwd_kernel, dim3(grid), dim3(512), LDS_BYTES, stream, a);
        (void)hipMemsetAsync((char*)d_ws + WS_CTL, 0, CTL_ZERO_BYTES, stream);
        a.ph_lo = PROBE_SPLIT; a.ph_hi = NPH; hipLaunchKernelGGL(fwd_kernel, dim3(grid), dim3(512), LDS_BYTES, stream, a); }
    else if (MK_N_LAUNCHES == 1) { a.ph_lo = 0; a.ph_hi = NPH; hipLaunchKernelGGL(fwd_kernel, dim3(grid), dim3(512), LDS_BYTES, stream, a); }
    else { for (int p = 0; p < NPH; ++p) { a.ph_lo = p; a.ph_hi = p + 1; hipLaunchKernelGGL(fwd_kernel, dim3(grid), dim3(512), LDS_BYTES, stream, a); } }
    const hipError_t le = hipPeekAtLastError();
    if (le != hipSuccess) fprintf(stderr, "kernel_launch: launch failed: %s\n", hipGetErrorName(le));
}
```

```cpp
#include <hip/hip_runtime.h>
#include <cstdio>
#include <cstdint>

#ifndef MK_N_LAUNCHES
#define MK_N_LAUNCHES 1
#endif

#ifndef PHASE_MASK
#define PHASE_MASK 0xff
#endif
#ifndef SELFCHECK
#define SELFCHECK 0
#endif
#ifndef SELFCHECK_BUG
#define SELFCHECK_BUG 0
#endif
#ifndef PROBE_SPLIT
#define PROBE_SPLIT -1
#endif
#define LAS __attribute__((address_space(3)))
typedef unsigned short bf16_t;
typedef short bf16x8 __attribute__((ext_vector_type(8)));
typedef short s16x4 __attribute__((ext_vector_type(4)));
typedef float f32x4 __attribute__((ext_vector_type(4)));
typedef float f32x2 __attribute__((ext_vector_type(2)));
typedef float f32x8 __attribute__((ext_vector_type(8)));
typedef float f32x16 __attribute__((ext_vector_type(16)));
typedef unsigned u32x4 __attribute__((ext_vector_type(4)));
typedef unsigned u32x2 __attribute__((ext_vector_type(2)));

constexpr int SEQ = 16384, DM = 2048, NIN = 7680, QW = 1024, KVW = 256, SGW = 1024, HD = 128;
constexpr int NPH = 8;
constexpr float EPS = 1e-6f;

constexpr size_t MiB = 1u << 20;
constexpr size_t WS_CTL = 0, CTL_ZERO_BYTES = 1 * MiB;
constexpr size_t WS_RSTD1 = 1 * MiB;
constexpr size_t WS_RSX = 1 * MiB + 64 * 1024;
constexpr size_t WS_SWG = 1 * MiB + 256 * 1024;
constexpr size_t WS_SU = 1 * MiB + 128 * 1024, WS_SV = 1 * MiB + 192 * 1024;
constexpr size_t WS_SSQV = 2 * MiB;
constexpr size_t WS_SSQ2 = 3 * MiB;
constexpr size_t WS_K1 = 5 * MiB, WS_K2 = WS_K1 + 256 * 1024, WS_WSGU = WS_K2 + 256 * 1024;
constexpr size_t WS_PCAT = 6 * MiB;
constexpr size_t WS_WOUT = 14 * MiB;
constexpr size_t WS_WPQ = 22 * MiB;
constexpr size_t WS_B = 30 * MiB;
constexpr size_t WS_C = 94 * MiB;
constexpr size_t WS_D = 124 * MiB;
constexpr size_t WS_E = 236 * MiB;
constexpr size_t WS_F = 300 * MiB;
constexpr size_t WS_X8 = WS_B, WS_WG8 = WS_C;
constexpr size_t WS_DBGK = 492 * MiB, WS_DBGS = 500 * MiB;
constexpr size_t WS_END = SELFCHECK ? 504 * MiB : 492 * MiB;
constexpr int QROWS_P1 = 3072;
constexpr size_t WS_Q = WS_D, WS_K = WS_D + 32 * MiB, WS_V = WS_D + 40 * MiB, WS_GU = WS_D + 48 * MiB, WS_GV = WS_D + 80 * MiB;
constexpr size_t WS_EIDX = WS_C, WS_GATE = WS_C + 8 * MiB, WS_USU = WS_C + 16 * MiB;
constexpr size_t WS_UT = 428 * MiB, WS_VT = 460 * MiB;
constexpr int CW_BAR = 4096, CW_CHK = 64;

constexpr int RING_BYTES = 131072;
constexpr int MISC_OFF = RING_BYTES;
constexpr int RS2_OFF = RING_BYTES + 256;
constexpr int LDS_BYTES = 147456;

__device__ __forceinline__ unsigned cvt_pk_bf16(float lo, float hi) { unsigned r; asm volatile("v_cvt_pk_bf16_f32 %0, %1, %2" : "=v"(r) : "v"(lo), "v"(hi)); return r; }
__device__ __forceinline__ float bf_lo(unsigned w) { return __uint_as_float(w << 16); }
__device__ __forceinline__ float bf_hi(unsigned w) { return __uint_as_float(w & 0xffff0000u); }
__device__ __forceinline__ float wave_sum(float v) {
#pragma unroll
    for (int o = 1; o < 64; o <<= 1) v += __shfl_xor(v, o);
    return v;
}
__device__ __forceinline__ float gelu_tanh(float x) {
    const float u = x * (0.7978845608028654f + 0.035677408136300125f * x * x);
    const float e = __builtin_amdgcn_exp2f(-2.885390081777927f * u);
    return x * __builtin_amdgcn_rcpf(1.0f + e);
}
#define TRANS_FENCE2(a, b) asm volatile("s_nop 0" : "+v"(a), "+v"(b))
__device__ __forceinline__ float sat8(float x) { return __builtin_amdgcn_fmed3f(x, -448.0f, 448.0f); }
__device__ __forceinline__ float sigmoidf_(float x) { return __builtin_amdgcn_rcpf(1.0f + __builtin_amdgcn_exp2f(-1.4426950408889634f * x)); }

#define XB_TMO      128
#define XB_XCNT(j)  (256  + 64 * (j))
#define XB_XSUB(j)  (1280 + 64 * (j))
#define XB_XGEN(j)  (2304 + 64 * (j))
#define XB_TOP      3328
#define XB_TOPGEN   3392
#define XCD_BAR_WORDS 3456
#define XB_SPIN_CAP (1u << 18)
__device__ __forceinline__ unsigned xb_ld(unsigned* p)              { return __hip_atomic_load(p, __ATOMIC_RELAXED, __HIP_MEMORY_SCOPE_AGENT); }
__device__ __forceinline__ unsigned xb_add(unsigned* p, unsigned v) { return __hip_atomic_fetch_add(p, v, __ATOMIC_RELAXED, __HIP_MEMORY_SCOPE_AGENT); }
__device__ __forceinline__ unsigned xb_xcc_id() { return (unsigned)__builtin_amdgcn_s_getreg((3 << 11) | 20) & 0xFu; }
#define XB_SPIN(cond, bar) do { unsigned _sp = 0; while (cond) { __builtin_amdgcn_s_sleep(1); \
    if ((++_sp & 255u) == 0u) { if (xb_ld(&(bar)[XB_TMO])) break; if (_sp > XB_SPIN_CAP) { atomicAdd(&(bar)[XB_TMO], 1u); break; } } } } while (0)
struct XcdBarrier { unsigned* bar; unsigned x; volatile LAS unsigned* st; };
__device__ __forceinline__ XcdBarrier xcd_barrier_post(unsigned* bar, volatile LAS unsigned* st) {
    XcdBarrier b; b.bar = bar; b.x = xb_xcc_id(); b.st = st;
    if (threadIdx.x == 0) (void)xb_add(&bar[XB_XCNT(b.x)], 1u);
    return b;
}
__device__ __forceinline__ void xcd_barrier_complete(unsigned* bar, unsigned x, unsigned& nloc, unsigned& nx) {
    const unsigned G = gridDim.x * gridDim.y * gridDim.z;
    unsigned sum, cnt, mine, sp = 0u;
    for (;;) {
        sum = 0u; cnt = 0u; mine = 0u;
#pragma unroll
        for (unsigned j = 0; j < 16; ++j) { const unsigned c = xb_ld(&bar[XB_XCNT(j)]); sum += c; cnt += (c > 0u) ? 1u : 0u; mine = (j == x) ? c : mine; }
        if (sum == G) break;
        __builtin_amdgcn_s_sleep(1);
        if ((++sp & 255u) == 0u) { if (xb_ld(&bar[XB_TMO])) break; if (sp > XB_SPIN_CAP) { atomicAdd(&bar[XB_TMO], 1u); break; } }
    }
    nloc = mine > 0u ? mine : 1u; nx = cnt > 0u ? cnt : 1u;
}
__device__ __forceinline__ void xcd_barrier(const XcdBarrier& b) {
    asm volatile("s_waitcnt vmcnt(0)" ::: "memory");
    __syncthreads();
    if (threadIdx.x == 0) {
        unsigned* bar = b.bar;
        __builtin_amdgcn_s_waitcnt(0);
        unsigned nloc = b.st[0], nx = b.st[1];
        if (nloc == 0u) { xcd_barrier_complete(bar, b.x, nloc, nx); b.st[0] = nloc; b.st[1] = nx; }
        const unsigned old = xb_add(&bar[XB_XSUB(b.x)], 1u);
        const unsigned gen = old / nloc;
        if (old + 1u == (gen + 1u) * nloc) {
            __builtin_amdgcn_fence(__ATOMIC_RELEASE, "agent");
            asm volatile("s_waitcnt vmcnt(0)" ::: "memory");
            const unsigned og = xb_add(&bar[XB_TOP], 1u);
            const unsigned tg = og / nx;
            if (og + 1u == (tg + 1u) * nx) xb_add(&bar[XB_TOPGEN], 1u);
            else XB_SPIN(xb_ld(&bar[XB_TOPGEN]) == tg, bar);
            __builtin_amdgcn_fence(__ATOMIC_ACQUIRE, "agent");
            xb_add(&bar[XB_XGEN(b.x)], 1u);
            asm volatile("s_waitcnt vmcnt(0)" ::: "memory");
        } else {
            XB_SPIN(xb_ld(&bar[XB_XGEN(b.x)]) == gen, bar);
            __builtin_amdgcn_fence(__ATOMIC_ACQUIRE, "agent");
            asm volatile("s_waitcnt vmcnt(0)" ::: "memory");
        }
    }
    __syncthreads();
}

namespace pg8 {
constexpr int BM = 256, BK = 64, HALF = 128, HTB = HALF * BK * 2, STAGE_BYTES = 8 * HTB, NXCD = 8, WGM = 8;
__host__ __device__ __forceinline__ int lds_byte(int r, int c) { const int st = (r >> 4) * 2 + (c >> 5), rr = r & 15, cc = c & 31, ob = rr * 64 + cc * 2; return st * 1024 + (ob ^ (((ob >> 9) & 1) << 5)); }
__host__ __device__ __forceinline__ void stage_rc(int b, int& R, int& C) { const int st = b / 1024, sb = b % 1024, swz = sb ^ (((sb >> 9) & 1) << 5); R = (st >> 1) * 16 + swz / 64; C = (st & 1) * 32 + (swz % 64) / 2; }
__host__ __device__ __forceinline__ int perm32(int rho) { const int n = rho >> 4, i = rho & 15; return 8 * (i >> 2) + 4 * n + (i & 3); }

struct Unit { int pm, pn, koff; };
struct Gemm { const bf16_t* A; const bf16_t* Bt; int lda, ldb, K; };

struct Order2D {
    int nM, nN, nwg, G, c;
    __device__ void init(int nM_, int nN_, int G_, int c_) { nM = nM_; nN = nN_; nwg = nM * nN; G = G_; c = c_; }
    __device__ void tile(int L, int& pm, int& pn) const {
        int wgid = L; { const int q = nwg / NXCD, r = nwg % NXCD, xcd = wgid % NXCD, off = wgid / NXCD; wgid = (xcd < r ? xcd * (q + 1) : r * (q + 1) + (xcd - r) * q) + off; }
        const int nig = WGM * nN, gid = wgid / nig, fm = gid * WGM, gsz = (nM - fm) < WGM ? (nM - fm) : WGM;
        pm = fm + ((wgid % nig) % gsz); pn = (wgid % nig) / gsz;
    }
    __device__ bool next(int i, Unit& u) const { const long L = (long)i * G + c; if (L >= nwg) return false; tile((int)L, u.pm, u.pn); u.koff = 0; return true; }
};
struct P1Order : Order2D {
    __device__ bool next(int i, Unit& u) const { const long L = (long)i * G + c; if (L >= nwg) return false; tile((int)L, u.pm, u.pn); u.pn = (u.pn >= 4 && u.pn < 8) ? (u.pn ^ 2) : u.pn; u.koff = 0; return true; }
};
struct ProjOrder : Order2D {
    __device__ bool next(int i, Unit& u) const { const long L = (long)(i >> 1) * G + c; if (L >= nwg) return false; tile((int)L, u.pm, u.pn); u.koff = (i & 1) * 1024; return true; }
};

typedef int i32x8 __attribute__((ext_vector_type(8)));
template <class Epi, class Sched, bool FP8 = false>
__device__ __forceinline__ void gemm_phase(LAS unsigned char* lds, const Gemm g, const Sched& S, const Epi& E) {
    const int tid = threadIdx.x, wid = __builtin_amdgcn_readfirstlane(tid >> 6), lane = tid & 63, wr = wid >> 2, wc = wid & 3, fr = lane & 15, fq = lane >> 4;
    const int nt = g.K / BK;
    unsigned voffA[2], voffB[2];
#pragma unroll
    for (int i = 0; i < 2; ++i) { int R, C; stage_rc(tid * 16 + i * 8192, R, C); const int Rb = Epi::PERM ? ((R & ~31) + perm32(R & 31)) : R;
        voffA[i] = (unsigned)(R * g.lda + C) * 2u; voffB[i] = (unsigned)(Rb * g.ldb + C) * 2u; }
    const size_t kstep = (size_t)(BK * 2);
    const size_t hstepA = (size_t)HALF * g.lda * 2, hstepB = (size_t)HALF * g.ldb * 2;
    const size_t tstepA = 2 * hstepA, tstepB = 2 * hstepB;
    const unsigned ldsw = (unsigned)wid * 1024u;
    const int aoff = lds_byte(wr * 64 + fr, fq * 8), boff = lds_byte(wc * 32 + fr, fq * 8);
#define PG8_SA(b, h) (((b) * 2 + (h)) * HTB)
#define PG8_SB(b, h) ((4 + (b) * 2 + (h)) * HTB)
#define PG8_STAGE(bufoff, gbase, voff) do { _Pragma("unroll") for (int _i = 0; _i < 2; ++_i) \
        __builtin_amdgcn_global_load_lds((const unsigned*)((const char*)(gbase) + (voff)[_i]), (LAS unsigned*)(lds + (bufoff) + ldsw + _i * 8192), 16, 0, 0); } while (0)
#define PG8_LDA(dst, b, h) do { _Pragma("unroll") for (int m = 0; m < 4; ++m) { dst[m].lo = *(const LAS bf16x8*)(lds + PG8_SA(b, h) + aoff + m * 2048); dst[m].hi = *(const LAS bf16x8*)(lds + PG8_SA(b, h) + aoff + m * 2048 + 1024); } } while (0)
#define PG8_LDB(dst, b, h) do { _Pragma("unroll") for (int n = 0; n < 2; ++n) { dst[n].lo = *(const LAS bf16x8*)(lds + PG8_SB(b, h) + boff + n * 2048); dst[n].hi = *(const LAS bf16x8*)(lds + PG8_SB(b, h) + boff + n * 2048 + 1024); } } while (0)
#define PG8_MMA(ai, bj, At, Bt) do { __builtin_amdgcn_s_setprio(1); _Pragma("unroll") for (int m = 0; m < 4; ++m) _Pragma("unroll") for (int n = 0; n < 2; ++n) { \
        if constexpr (FP8) { asm volatile("v_mfma_scale_f32_16x16x128_f8f6f4 %0, %1, %2, %0, %3, %3 op_sel_hi:[0,0,0]" : "+v"(acc[ai][bj][m][n]) : "v"(__builtin_bit_cast(i32x8, Bt[n])), "v"(__builtin_bit_cast(i32x8, At[m])), "v"(0x7F7F7F7F)); }     \
        else { acc[ai][bj][m][n] = __builtin_amdgcn_mfma_f32_16x16x32_bf16(Bt[n].lo, At[m].lo, acc[ai][bj][m][n], 0, 0, 0); acc[ai][bj][m][n] = __builtin_amdgcn_mfma_f32_16x16x32_bf16(Bt[n].hi, At[m].hi, acc[ai][bj][m][n], 0, 0, 0); } } __builtin_amdgcn_s_setprio(0); } while (0)
#define PG8_WAIT_V(n) asm volatile("s_waitcnt vmcnt(" #n ")" ::: "memory")
#define PG8_WAIT_L(n) asm volatile("s_waitcnt lgkmcnt(" #n ")" ::: "memory")
#define PG8_BAR __builtin_amdgcn_s_barrier()
#define PG8_SCHED __builtin_amdgcn_sched_barrier(0)
#define PG8_FENCE do { } while (0)
    Unit cur, nxt; int ui = 0;
    if (!S.next(0, cur)) return;
    f32x4 acc[2][2][4][2];
#pragma unroll
    for (int a = 0; a < 2; ++a)
#pragma unroll
        for (int b = 0; b < 2; ++b)
#pragma unroll
            for (int m = 0; m < 4; ++m)
#pragma unroll
                for (int n = 0; n < 2; ++n) acc[a][b][m][n] = (f32x4){0.f, 0.f, 0.f, 0.f};
    typedef short bf16x16 __attribute__((ext_vector_type(16)));
    bf16x16 At[4], B0[2], B1[2];
    const char* cA = (const char*)g.A + (size_t)cur.pm * tstepA + (size_t)cur.koff * 2; const char* cB = (const char*)g.Bt + (size_t)cur.pn * tstepB + (size_t)cur.koff * 2;
    PG8_STAGE(PG8_SB(0, 0), cB, voffB); PG8_STAGE(PG8_SB(0, 1), cB + hstepB, voffB); PG8_STAGE(PG8_SA(0, 0), cA, voffA); PG8_STAGE(PG8_SA(0, 1), cA + hstepA, voffA);
    if (wr == 1) PG8_BAR;
    PG8_WAIT_V(2); PG8_BAR;
    PG8_STAGE(PG8_SB(1, 0), cB + kstep, voffB); PG8_STAGE(PG8_SA(1, 0), cA + kstep, voffA); PG8_STAGE(PG8_SB(1, 1), cB + hstepB + kstep, voffB);
    PG8_WAIT_V(6); PG8_BAR;
    for (;;) {
        const bool has_next = S.next(ui + 1, nxt);
        const char* nA = has_next ? (const char*)g.A + (size_t)nxt.pm * tstepA + (size_t)nxt.koff * 2 : cA; const char* nB = has_next ? (const char*)g.Bt + (size_t)nxt.pn * tstepB + (size_t)nxt.koff * 2 : cB;
        for (int t = 0; t < nt; t += 2) {
            if constexpr (Epi::MID) { if (t == nt / 2) E.mid(acc, cur, wr, wc, fr, fq); }
            const bool last = (t == nt - 2);
            const char* a1 = cA + (size_t)(t + 1) * kstep;
            const char* a2 = last ? nA : cA + (size_t)(t + 2) * kstep; const char* b2 = last ? nB : cB + (size_t)(t + 2) * kstep;
            const char* a3 = a2 + kstep; const char* b3 = b2 + kstep;
            PG8_LDB(B0, 0, 0); PG8_LDB(B1, 0, 1); PG8_SCHED; PG8_LDA(At, 0, 0); PG8_STAGE(PG8_SA(1, 1), a1 + hstepA, voffA);
            PG8_WAIT_V(8); PG8_WAIT_L(0); PG8_BAR; PG8_MMA(0, 0, At, B0); PG8_MMA(0, 1, At, B1); PG8_FENCE; PG8_BAR; PG8_SCHED;
            PG8_LDA(At, 0, 1); PG8_STAGE(PG8_SB(0, 0), b2, voffB); PG8_STAGE(PG8_SB(0, 1), b2 + hstepB, voffB); PG8_STAGE(PG8_SA(0, 0), a2, voffA);
            PG8_WAIT_V(8); PG8_WAIT_L(0); PG8_BAR; PG8_MMA(1, 0, At, B0); PG8_MMA(1, 1, At, B1); PG8_FENCE; PG8_BAR; PG8_SCHED;
            PG8_LDB(B0, 1, 0); PG8_LDB(B1, 1, 1); PG8_SCHED; PG8_LDA(At, 1, 0); PG8_STAGE(PG8_SA(0, 1), a2 + hstepA, voffA);
            PG8_WAIT_V(8); PG8_WAIT_L(0); PG8_BAR; PG8_MMA(0, 0, At, B0); PG8_MMA(0, 1, At, B1); PG8_FENCE; PG8_BAR; PG8_SCHED;
            PG8_LDA(At, 1, 1); PG8_STAGE(PG8_SB(1, 0), b3, voffB); PG8_STAGE(PG8_SB(1, 1), b3 + hstepB, voffB); PG8_STAGE(PG8_SA(1, 0), a3, voffA);
            PG8_WAIT_V(8); PG8_WAIT_L(0); PG8_BAR; PG8_MMA(1, 0, At, B0); PG8_MMA(1, 1, At, B1); PG8_FENCE; PG8_BAR; PG8_SCHED;
        }
        if (wr == 0) PG8_BAR;
        if constexpr (FP8) asm volatile("s_nop 15\n\ts_nop 15\n\ts_nop 15\n\ts_nop 15\n\ts_nop 15\n\ts_nop 15" ::: "memory");
        E(acc, cur, wr, wc, fr, fq, ui);
        if (!has_next) break;
#pragma unroll
        for (int a = 0; a < 2; ++a)
#pragma unroll
            for (int b = 0; b < 2; ++b)
#pragma unroll
                for (int m = 0; m < 4; ++m)
#pragma unroll
                    for (int n = 0; n < 2; ++n) acc[a][b][m][n] = (f32x4){0.f, 0.f, 0.f, 0.f};
        cur = nxt; cA = nA; cB = nB; ++ui;
        if (wr == 1) PG8_BAR;
    }
    PG8_WAIT_V(0);
    PG8_BAR;
#undef PG8_SA
#undef PG8_SB
#undef PG8_STAGE
#undef PG8_LDA
#undef PG8_LDB
#undef PG8_MMA
#undef PG8_WAIT_V
#undef PG8_WAIT_L
#undef PG8_BAR
#undef PG8_SCHED
#undef PG8_FENCE
}

struct Epi1 {
    static constexpr bool PERM = true, MID = false;
    const float* rsx; const float* sw; bf16_t *q, *k, *v, *gu, *gv, *gates; const float* b_gate; float* ssqv; const float* k_norm; LAS float* xch; bf16_t* kraw_dbg; unsigned char* vt8;
    __device__ __forceinline__ void k_tile(f32x4 (&acc)[2][2][4][2], const Unit& u, int wr, int wc, int fr, int fq) const {
        const int rl0 = wr * 64 + fr, cb = wc * 32 + 8 * fq;
        float rsv[2][4];
#pragma unroll
        for (int ai = 0; ai < 2; ++ai)
#pragma unroll
            for (int m = 0; m < 4; ++m) rsv[ai][m] = rsx[u.pm * BM + rl0 + ai * HALF + m * 16];
        f32x4 swv[2][2];
#pragma unroll
        for (int bj = 0; bj < 2; ++bj)
#pragma unroll
            for (int n = 0; n < 2; ++n) swv[bj][n] = *(const f32x4*)(sw + 4 * BM + bj * HALF + cb + 4 * n);
#pragma unroll
        for (int ai = 0; ai < 2; ++ai)
#pragma unroll
            for (int m = 0; m < 4; ++m)
#pragma unroll
                for (int bj = 0; bj < 2; ++bj) { const f32x4 v0 = acc[ai][bj][m][0] * rsv[ai][m] * swv[bj][0], v1 = acc[ai][bj][m][1] * rsv[ai][m] * swv[bj][1];
                    acc[ai][bj][m][0] = v0; acc[ai][bj][m][1] = v1;
                    float ss = (v0[0] * v0[0] + v0[1] * v0[1]) + (v0[2] * v0[2] + v0[3] * v0[3]) + (v1[0] * v1[0] + v1[1] * v1[1]) + (v1[2] * v1[2] + v1[3] * v1[3]);
                    ss += __shfl_xor(ss, 16); ss += __shfl_xor(ss, 32);
                    if (fq == 0) xch[((rl0 + ai * HALF + m * 16) * 2 + bj) * 4 + wc] = ss; }
        asm volatile("s_waitcnt lgkmcnt(0)" ::: "memory"); __builtin_amdgcn_s_barrier(); asm volatile("" ::: "memory");
        const f32x4 g0 = *(const f32x4*)(k_norm + cb), g1 = *(const f32x4*)(k_norm + cb + 4);
        float inv[4];
#pragma unroll
        for (int jj = 0; jj < 4; ++jj) inv[jj] = __builtin_amdgcn_exp2f(-(float)(16 * (wc & 1) + 4 * fq + jj) * (13.287712379549449f / 32.0f)) * 0.15915494309189535f;
#pragma unroll
        for (int ai = 0; ai < 2; ++ai)
#pragma unroll
            for (int m = 0; m < 4; ++m) {
                const int rl = rl0 + ai * HALF + m * 16, t = u.pm * BM + rl;
                const float pos = (float)((wc < 2) ? (t >> 6) : (t & 63));
                float cs[4], sn[4];
#pragma unroll
                for (int jj = 0; jj < 4; ++jj) { const float rev = pos * inv[jj], fr_ = rev - floorf(rev); cs[jj] = __builtin_amdgcn_cosf(fr_); sn[jj] = __builtin_amdgcn_sinf(fr_); }
#pragma unroll
                for (int bj = 0; bj < 2; ++bj) {
                    const f32x4 pp = *(const LAS f32x4*)(xch + (rl * 2 + bj) * 4);
                    const float rs = 1.0f / sqrtf(((pp[0] + pp[1]) + (pp[2] + pp[3])) * (1.0f / HD) + EPS);
                    const f32x4 z0 = acc[ai][bj][m][0], z1 = acc[ai][bj][m][1];
                    if (kraw_dbg) { u32x4 w; w.x = cvt_pk_bf16(z0[0], z0[1]); w.y = cvt_pk_bf16(z0[2], z0[3]); w.z = cvt_pk_bf16(z1[0], z1[1]); w.w = cvt_pk_bf16(z1[2], z1[3]); *(u32x4*)(kraw_dbg + (size_t)t * KVW + bj * HALF + cb) = w; }
                    const f32x4 y0 = z0 * rs * g0, y1 = z1 * rs * g1;
                    f32x4 e0, e1;
                    e0[0] = y0[0] * cs[0] - y0[1] * sn[0]; e0[1] = y0[0] * sn[0] + y0[1] * cs[0]; e0[2] = y0[2] * cs[1] - y0[3] * sn[1]; e0[3] = y0[2] * sn[1] + y0[3] * cs[1];
                    e1[0] = y1[0] * cs[2] - y1[1] * sn[2]; e1[1] = y1[0] * sn[2] + y1[1] * cs[2]; e1[2] = y1[2] * cs[3] - y1[3] * sn[3]; e1[3] = y1[2] * sn[3] + y1[3] * cs[3];
                    TRANS_FENCE2(e0, e1);
                    int w0 = 0, w1 = 0;
                    w0 = __builtin_amdgcn_cvt_pk_fp8_f32(sat8(e0[0]), sat8(e0[1]), w0, false); w0 = __builtin_amdgcn_cvt_pk_fp8_f32(sat8(e0[2]), sat8(e0[3]), w0, true);
                    w1 = __builtin_amdgcn_cvt_pk_fp8_f32(sat8(e1[0]), sat8(e1[1]), w1, false); w1 = __builtin_amdgcn_cvt_pk_fp8_f32(sat8(e1[2]), sat8(e1[3]), w1, true);
                    u32x2 w; w.x = (unsigned)w0; w.y = (unsigned)w1;
                    *(u32x2*)((unsigned char*)k + (size_t)t * KVW + bj * HALF + (wc >> 1) * 64 + (fq & 1) * 32 + ((wc & 1) * 2 + (fq >> 1)) * 8) = w;
                }
            }
    }
    __device__ __forceinline__ void v_tile(const f32x4 (&acc)[2][2][4][2], const Unit& u, int wr, int wc, int fr, int fq) const {
        asm volatile("" : "+v"(fr), "+v"(fq));
        const int row0 = u.pm * BM + wr * 64 + fr, cw = wc * 32 + 8 * fq;
#pragma unroll
        for (int ai = 0; ai < 2; ++ai)
#pragma unroll
            for (int m = 0; m < 4; ++m) {
                const int r = row0 + ai * HALF + m * 16; const float rs = rsx[r];
                const int kk = r & 63, pos = ((kk >> 2) & 1) * 32 + (kk >> 5) * 16 + (kk & 3) + 4 * ((kk & 31) >> 3);
#pragma unroll
                for (int bj = 0; bj < 2; ++bj) {
                    const f32x4 s0 = *(const f32x4*)(sw + 5 * BM + bj * HALF + cw), s1 = *(const f32x4*)(sw + 5 * BM + bj * HALF + cw + 4);
                    const f32x4 v0 = acc[ai][bj][m][0] * rs * s0, v1 = acc[ai][bj][m][1] * rs * s1;
                    u32x4 w; w.x = cvt_pk_bf16(v0[0], v0[1]); w.y = cvt_pk_bf16(v0[2], v0[3]); w.z = cvt_pk_bf16(v1[0], v1[1]); w.w = cvt_pk_bf16(v1[2], v1[3]);
                    *(u32x4*)(v + (size_t)r * KVW + bj * HALF + cw) = w;
                    unsigned char* vp = vt8 + (((size_t)(r >> 6) * 2 + bj) * 128 + cw) * 64 + pos;
                    int f0 = 0, f1 = 0;
                    f0 = __builtin_amdgcn_cvt_pk_fp8_f32(sat8(v0[0]), sat8(v0[1]), f0, false); f0 = __builtin_amdgcn_cvt_pk_fp8_f32(sat8(v0[2]), sat8(v0[3]), f0, true);
                    f1 = __builtin_amdgcn_cvt_pk_fp8_f32(sat8(v1[0]), sat8(v1[1]), f1, false); f1 = __builtin_amdgcn_cvt_pk_fp8_f32(sat8(v1[2]), sat8(v1[3]), f1, true);
                    vp[0] = (unsigned char)f0; vp[64] = (unsigned char)(f0 >> 8); vp[128] = (unsigned char)(f0 >> 16); vp[192] = (unsigned char)(f0 >> 24);
                    vp[256] = (unsigned char)f1; vp[320] = (unsigned char)(f1 >> 8); vp[384] = (unsigned char)(f1 >> 16); vp[448] = (unsigned char)(f1 >> 24);
                }
                __builtin_amdgcn_sched_barrier(0);
            }
    }
    __device__ __forceinline__ void operator()(f32x4 (&acc)[2][2][4][2], const Unit& u, int wr, int wc, int fr, int fq, int) const {
        if (u.pn == 4) { k_tile(acc, u, wr, wc, fr, fq); return; }
        if (u.pn == 5) { v_tile(acc, u, wr, wc, fr, fq); return; }
        const int row0 = u.pm * BM + wr * 64 + fr, pn = u.pn;
        bf16_t* dst; int ldc, colt, mode;
        if (pn < 4) { dst = q; ldc = QW; colt = pn * 256; mode = 0; }
        else if (pn == 5) { dst = v; ldc = KVW; colt = 0; mode = 0; }
        else if (pn < 10) { dst = gu; ldc = SGW; colt = (pn - 6) * 256; mode = 1; }
        else if (pn < 14) { dst = gv; ldc = SGW; colt = (pn - 10) * 256; mode = 2; }
        else { dst = gates; ldc = 4096; colt = (pn - 14) * 256; mode = 3; }
        const int cw = wc * 32 + 8 * fq, col0 = colt + cw;
        float rsv[2][4];
#pragma unroll
        for (int ai = 0; ai < 2; ++ai)
#pragma unroll
            for (int m = 0; m < 4; ++m) rsv[ai][m] = rsx[row0 + ai * HALF + m * 16];
        f32x4 bv[2][2], swv[2][2];
#pragma unroll
        for (int bj = 0; bj < 2; ++bj)
#pragma unroll
            for (int n = 0; n < 2; ++n) { bv[bj][n] = (mode == 3) ? *(const f32x4*)(b_gate + col0 + bj * HALF + 4 * n) : (f32x4){0.f, 0.f, 0.f, 0.f};
                swv[bj][n] = *(const f32x4*)(sw + pn * BM + cw + bj * HALF + 4 * n); }
#pragma unroll
        for (int ai = 0; ai < 2; ++ai)
#pragma unroll
            for (int m = 0; m < 4; ++m) {
                const int r = row0 + ai * HALF + m * 16; const float rs = rsv[ai][m];
                bf16_t* rowp = dst + (size_t)r * ldc + col0; float ss = 0.f;
#pragma unroll
                for (int bj = 0; bj < 2; ++bj) {
                    f32x4 v0 = acc[ai][bj][m][0] * rs * swv[bj][0], v1 = acc[ai][bj][m][1] * rs * swv[bj][1];
                    if (mode == 1 || mode == 2) {
#pragma unroll
                        for (int j = 0; j < 4; ++j) { v0[j] = gelu_tanh(v0[j]); v1[j] = gelu_tanh(v1[j]); }
                        if (mode == 2) {
#pragma unroll
                            for (int j = 0; j < 4; ++j) ss += v0[j] * v0[j] + v1[j] * v1[j];
                        }
                    } else if (mode == 3) {
                        v0 = v0 + bv[bj][0]; v1 = v1 + bv[bj][1];
#pragma unroll
                        for (int j = 0; j < 4; ++j) { v0[j] = sigmoidf_(v0[j]); v1[j] = sigmoidf_(v1[j]); }
                    }
                    TRANS_FENCE2(v0, v1);
                    u32x4 w; w.x = cvt_pk_bf16(v0[0], v0[1]); w.y = cvt_pk_bf16(v0[2], v0[3]); w.z = cvt_pk_bf16(v1[0], v1[1]); w.w = cvt_pk_bf16(v1[2], v1[3]);
                    *(u32x4*)(rowp + bj * HALF) = w;
                }
                if (mode == 2) { ss += __shfl_xor(ss, 16); ss += __shfl_xor(ss, 32); if (fq == 0) ssqv[(size_t)r * 16 + (pn - 10) * 4 + wc] = ss; }
            }
    }
};
struct Epi3 {
    static constexpr bool PERM = true, MID = true;
    unsigned char* ws;
    __device__ __forceinline__ void mid(f32x4 (&acc)[2][2][4][2], const Unit& u, int wr, int wc, int fr, int fq) const {
        asm volatile("" : "+v"(fr), "+v"(fq));
        const int row0 = u.pm * BM + wr * 64 + fr, col0 = u.pn * BM + wc * 32 + 8 * fq;
        const bf16_t* gates = (const bf16_t*)(ws + WS_F);
#pragma unroll
        for (int ai = 0; ai < 2; ++ai) {
            u32x4 ga[4][2], gs[4][2];
#pragma unroll
            for (int m = 0; m < 4; ++m)
#pragma unroll
                for (int bj = 0; bj < 2; ++bj) { const int r = row0 + ai * HALF + m * 16;
                    ga[m][bj] = __builtin_nontemporal_load((const u32x4*)(gates + (size_t)r * 4096 + col0 + bj * HALF));
                    gs[m][bj] = *(const u32x4*)(gates + (size_t)r * 4096 + 2048 + col0 + bj * HALF); }
#pragma unroll
            for (int m = 0; m < 4; ++m)
#pragma unroll
                for (int bj = 0; bj < 2; ++bj) { const u32x4 a = ga[m][bj], g = gs[m][bj];
                    f32x4 r0, r1;
                    r0[0] = bf_lo(a.x) * __builtin_amdgcn_rcpf(fmaxf(bf_lo(g.x), 1e-18f)); r0[1] = bf_hi(a.x) * __builtin_amdgcn_rcpf(fmaxf(bf_hi(g.x), 1e-18f));
                    r0[2] = bf_lo(a.y) * __builtin_amdgcn_rcpf(fmaxf(bf_lo(g.y), 1e-18f)); r0[3] = bf_hi(a.y) * __builtin_amdgcn_rcpf(fmaxf(bf_hi(g.y), 1e-18f));
                    r1[0] = bf_lo(a.z) * __builtin_amdgcn_rcpf(fmaxf(bf_lo(g.z), 1e-18f)); r1[1] = bf_hi(a.z) * __builtin_amdgcn_rcpf(fmaxf(bf_hi(g.z), 1e-18f));
                    r1[2] = bf_lo(a.w) * __builtin_amdgcn_rcpf(fmaxf(bf_lo(g.w), 1e-18f)); r1[3] = bf_hi(a.w) * __builtin_amdgcn_rcpf(fmaxf(bf_hi(g.w), 1e-18f));
                    acc[ai][bj][m][0] = acc[ai][bj][m][0] * r0; acc[ai][bj][m][1] = acc[ai][bj][m][1] * r1; }
        }
    }
    __device__ __forceinline__ void operator()(const f32x4 (&acc)[2][2][4][2], const Unit& u, int wr, int wc, int fr, int fq, int) const {
        const int row0 = u.pm * BM + wr * 64 + fr, col0 = u.pn * BM + wc * 32 + 8 * fq;
        const bf16_t* gates = (const bf16_t*)(ws + WS_F) + 2048;
        bf16_t* dst = (bf16_t*)(ws + WS_B);
#pragma unroll
        for (int ai = 0; ai < 2; ++ai) {
            u32x4 gw[4][2];
#pragma unroll
            for (int m = 0; m < 4; ++m)
#pragma unroll
                for (int bj = 0; bj < 2; ++bj) { const int r = row0 + ai * HALF + m * 16; gw[m][bj] = __builtin_nontemporal_load((const u32x4*)(gates + (size_t)r * 4096 + col0 + bj * HALF)); }
#pragma unroll
            for (int m = 0; m < 4; ++m)
#pragma unroll
                for (int bj = 0; bj < 2; ++bj) { const int r = row0 + ai * HALF + m * 16;
                    const u32x4 g = gw[m][bj];
                    f32x4 v0 = acc[ai][bj][m][0], v1 = acc[ai][bj][m][1];
                    v0[0] *= fmaxf(bf_lo(g.x), 1e-18f); v0[1] *= fmaxf(bf_hi(g.x), 1e-18f); v0[2] *= fmaxf(bf_lo(g.y), 1e-18f); v0[3] *= fmaxf(bf_hi(g.y), 1e-18f);
                    v1[0] *= fmaxf(bf_lo(g.z), 1e-18f); v1[1] *= fmaxf(bf_hi(g.z), 1e-18f); v1[2] *= fmaxf(bf_lo(g.w), 1e-18f); v1[3] *= fmaxf(bf_hi(g.w), 1e-18f);
                    u32x4 w; w.x = cvt_pk_bf16(v0[0], v0[1]); w.y = cvt_pk_bf16(v0[2], v0[3]); w.z = cvt_pk_bf16(v1[0], v1[1]); w.w = cvt_pk_bf16(v1[2], v1[3]);
                    *(u32x4*)(dst + (size_t)r * DM + col0 + bj * HALF) = w; }
        }
    }
};
struct Epi4 {
    static constexpr bool PERM = true, MID = false;
    const float* x; float* out; bf16_t* h1b; float* ssq2;
    __device__ __forceinline__ void operator()(const f32x4 (&acc)[2][2][4][2], const Unit& u, int wr, int wc, int fr, int fq, int) const {
        const int row0 = u.pm * BM + wr * 64 + fr, col0 = u.pn * BM + wc * 32 + 8 * fq;
#pragma unroll
        for (int ai = 0; ai < 2; ++ai) {
            f32x4 xv[4][2][2];
#pragma unroll
            for (int m = 0; m < 4; ++m)
#pragma unroll
                for (int bj = 0; bj < 2; ++bj) { const size_t off = (size_t)(row0 + ai * HALF + m * 16) * DM + col0 + bj * HALF;
                    xv[m][bj][0] = __builtin_nontemporal_load((const f32x4*)(x + off)); xv[m][bj][1] = __builtin_nontemporal_load((const f32x4*)(x + off + 4)); }
#pragma unroll
            for (int m = 0; m < 4; ++m) {
                const int r = row0 + ai * HALF + m * 16; float ss = 0.f;
#pragma unroll
                for (int bj = 0; bj < 2; ++bj) {
                    const size_t off = (size_t)r * DM + col0 + bj * HALF;
                    const f32x4 v0 = acc[ai][bj][m][0] + xv[m][bj][0], v1 = acc[ai][bj][m][1] + xv[m][bj][1];
#pragma unroll
                    for (int j = 0; j < 4; ++j) ss += v0[j] * v0[j] + v1[j] * v1[j];
                    u32x4 w; w.x = cvt_pk_bf16(v0[0], v0[1]); w.y = cvt_pk_bf16(v0[2], v0[3]); w.z = cvt_pk_bf16(v1[0], v1[1]); w.w = cvt_pk_bf16(v1[2], v1[3]);
                    *(u32x4*)(h1b + off) = w;
                }
                ss += __shfl_xor(ss, 16); ss += __shfl_xor(ss, 32);
                if (fq == 0) ssq2[(size_t)r * 32 + u.pn * 4 + wc] = ss;
            }
        }
    }
};
struct Epi5 {
    static constexpr bool PERM = true, MID = false;
    const LAS float* rs2; bf16_t* qp;
    __device__ __forceinline__ void operator()(const f32x4 (&acc)[2][2][4][2], const Unit& u, int wr, int wc, int fr, int fq, int ui) const {
        const int rl0 = wr * 64 + fr, col0 = u.pn * BM + wc * 32 + 8 * fq;
#pragma unroll
        for (int ai = 0; ai < 2; ++ai)
#pragma unroll
            for (int m = 0; m < 4; ++m) {
                const int rl = rl0 + ai * HALF + m * 16; const float rs = rs2[ui * 256 + rl];
#pragma unroll
                for (int bj = 0; bj < 2; ++bj) {
                    const f32x4 v0 = acc[ai][bj][m][0] * rs, v1 = acc[ai][bj][m][1] * rs;
                    u32x4 w; w.x = cvt_pk_bf16(v0[0], v0[1]); w.y = cvt_pk_bf16(v0[2], v0[3]); w.z = cvt_pk_bf16(v1[0], v1[1]); w.w = cvt_pk_bf16(v1[2], v1[3]);
                    *(u32x4*)(qp + (size_t)(u.pm * BM + rl) * DM + col0 + bj * HALF) = w;
                }
            }
    }
};
}

namespace att {
constexpr int D = 128, NW = 8, QBLK = 32, KVBLK = 64;
constexpr float SCALE = 0.088388347648318440f;
constexpr int LDQ = QW, LDK = KVW, LDO = 2048;
#define SBAR() __builtin_amdgcn_sched_barrier(0)
__device__ __forceinline__ int crow(int r, int hi) { return (r & 3) + 8 * (r >> 2) + 4 * hi; }
#define KSWZ8(row, colB) ((row) * 128 + ((colB) ^ ((((row) >> 1) & 7) << 4)))
typedef int i32x8 __attribute__((ext_vector_type(8)));
__device__ __forceinline__ void qkt8(f32x16& p0, f32x16& p1, const char* Ks, const i32x8 (&q8)[2], int r32, int hi, const f32x16& cinit) {
  p0 = cinit; p1 = cinit;
#pragma unroll
  for (int c = 0; c < 2; ++c) { const int cb = c * 64 + hi * 32;
    const u32x4 a0 = *reinterpret_cast<const u32x4*>(Ks + KSWZ8(r32, cb)), a1 = *reinterpret_cast<const u32x4*>(Ks + KSWZ8(r32, cb + 16));
    const u32x4 b0 = *reinterpret_cast<const u32x4*>(Ks + KSWZ8(32 + r32, cb)), b1 = *reinterpret_cast<const u32x4*>(Ks + KSWZ8(32 + r32, cb + 16));
    const i32x8 ka = {(int)a0.x, (int)a0.y, (int)a0.z, (int)a0.w, (int)a1.x, (int)a1.y, (int)a1.z, (int)a1.w}, kb2 = {(int)b0.x, (int)b0.y, (int)b0.z, (int)b0.w, (int)b1.x, (int)b1.y, (int)b1.z, (int)b1.w};
    p0 = __builtin_amdgcn_mfma_scale_f32_32x32x64_f8f6f4(ka, q8[c], p0, 0, 0, 0, 0, 0, 0);
    p1 = __builtin_amdgcn_mfma_scale_f32_32x32x64_f8f6f4(kb2, q8[c], p1, 0, 0, 0, 0, 0, 0); }
}
#define VSWZ8(d, chunk) ((d) * 64 + ((((chunk) ^ (((d) >> 2) & 3))) << 4))
__device__ __forceinline__ void pv8(f32x16* o, f32x16& lsum, const i32x8& ones8, const char* Vs, const i32x8& pa, int r32, int hi) {
  lsum = __builtin_amdgcn_mfma_scale_f32_32x32x64_f8f6f4(ones8, pa, lsum, 0, 0, 0, 0, 0, 0);
  const char* vb = Vs + VSWZ8(r32, 2 * hi); const char* vb1 = Vs + VSWZ8(r32, 2 * hi + 1);
#pragma unroll
  for (int d0 = 0; d0 < 4; ++d0) {
    const u32x4 a0 = *reinterpret_cast<const u32x4*>(vb + d0 * 2048), a1 = *reinterpret_cast<const u32x4*>(vb1 + d0 * 2048);
    const i32x8 vf = {(int)a0.x, (int)a0.y, (int)a0.z, (int)a0.w, (int)a1.x, (int)a1.y, (int)a1.z, (int)a1.w};
    o[d0] = __builtin_amdgcn_mfma_scale_f32_32x32x64_f8f6f4(vf, pa, o[d0], 0, 0, 0, 0, 0, 0); }
}
template <int SOFF> __device__ __forceinline__ void qkt8o(f32x16& p0, f32x16& p1, const char* ldsb, const int (&ko)[4], const i32x8 (&q8)[2], const f32x16& cinit) {
  p0 = cinit; p1 = cinit;
#pragma unroll
  for (int c = 0; c < 2; ++c) {
    const u32x4 a0 = *reinterpret_cast<const u32x4*>(ldsb + ko[2 * c] + SOFF), a1 = *reinterpret_cast<const u32x4*>(ldsb + ko[2 * c + 1] + SOFF);
    const u32x4 b0 = *reinterpret_cast<const u32x4*>(ldsb + ko[2 * c] + SOFF + 4096), b1 = *reinterpret_cast<const u32x4*>(ldsb + ko[2 * c + 1] + SOFF + 4096);
    const i32x8 ka = {(int)a0.x, (int)a0.y, (int)a0.z, (int)a0.w, (int)a1.x, (int)a1.y, (int)a1.z, (int)a1.w}, kb2 = {(int)b0.x, (int)b0.y, (int)b0.z, (int)b0.w, (int)b1.x, (int)b1.y, (int)b1.z, (int)b1.w};
    p0 = __builtin_amdgcn_mfma_scale_f32_32x32x64_f8f6f4(ka, q8[c], p0, 0, 0, 0, 0, 0, 0);
    p1 = __builtin_amdgcn_mfma_scale_f32_32x32x64_f8f6f4(kb2, q8[c], p1, 0, 0, 0, 0, 0, 0); }
}
template <int SOFF> __device__ __forceinline__ void pv8o(f32x16* o, f32x16& lsum, const i32x8& ones8, const char* ldsb, const int (&vo)[2], const i32x8& pa) {
  lsum = __builtin_amdgcn_mfma_scale_f32_32x32x64_f8f6f4(ones8, pa, lsum, 0, 0, 0, 0, 0, 0);
#pragma unroll
  for (int d0 = 0; d0 < 4; ++d0) {
    const u32x4 a0 = *reinterpret_cast<const u32x4*>(ldsb + vo[0] + SOFF + d0 * 2048), a1 = *reinterpret_cast<const u32x4*>(ldsb + vo[1] + SOFF + d0 * 2048);
    const i32x8 vf = {(int)a0.x, (int)a0.y, (int)a0.z, (int)a0.w, (int)a1.x, (int)a1.y, (int)a1.z, (int)a1.w};
    o[d0] = __builtin_amdgcn_mfma_scale_f32_32x32x64_f8f6f4(vf, pa, o[d0], 0, 0, 0, 0, 0, 0); }
}
constexpr float THR8 = 2.5f, POFF8 = 6.0f;
__device__ __forceinline__ void partialSM8(f32x16& p0, f32x16& p1, f32x16& cinit, float& alpha, bool first) {
  float pmax = p0[0]; for (int r = 1; r < 16; ++r) pmax = fmaxf(pmax, p0[r]); for (int r = 0; r < 16; ++r) pmax = fmaxf(pmax, p1[r]);
  { auto rr = __builtin_amdgcn_permlane32_swap(__float_as_uint(pmax), __float_as_uint(pmax), false, false);
    pmax = fmaxf(__uint_as_float(rr[0]), __uint_as_float(rr[1])); }
  if (__builtin_expect(!first && __all(pmax <= POFF8 + THR8), 1)) alpha = 1.f;
  else { const float d = first ? pmax - POFF8 : fmaxf(pmax - POFF8, 0.f);
    alpha = __builtin_amdgcn_exp2f(-d);
    for (int r = 0; r < 16; ++r) { p0[r] -= d; p1[r] -= d; cinit[r] -= d; } }
}
template <int R0> __device__ __forceinline__ void finishSM8(f32x16& p0, f32x16& p1, i32x8& pa) {
  for (int r = R0; r < 16; ++r) { p0[r] = __builtin_amdgcn_exp2f(p0[r]); p1[r] = __builtin_amdgcn_exp2f(p1[r]); }
  asm volatile("s_nop 0" : "+v"(p0), "+v"(p1));
#pragma unroll
  for (int j = 0; j < 4; ++j) { int w0 = pa[j], w1 = pa[4 + j];
    w0 = __builtin_amdgcn_cvt_pk_fp8_f32(p0[4 * j], p0[4 * j + 1], w0, false); w0 = __builtin_amdgcn_cvt_pk_fp8_f32(p0[4 * j + 2], p0[4 * j + 3], w0, true);
    w1 = __builtin_amdgcn_cvt_pk_fp8_f32(p1[4 * j], p1[4 * j + 1], w1, false); w1 = __builtin_amdgcn_cvt_pk_fp8_f32(p1[4 * j + 2], p1[4 * j + 3], w1, true);
    pa[j] = w0; pa[4 + j] = w1; }
}
#define EXPQ(j) do { _Pragma("unroll") for (int r = 4 * (j); r < 4 * (j) + 4; ++r) { y0[r] = __builtin_amdgcn_exp2f(y0[r]); y1[r] = __builtin_amdgcn_exp2f(y1[r]); } } while (0)
#define PACKQ(j) do { int w0 = pa[j], w1 = pa[4 + (j)]; \
    w0 = __builtin_amdgcn_cvt_pk_fp8_f32(y0[4 * (j)], y0[4 * (j) + 1], w0, false); w0 = __builtin_amdgcn_cvt_pk_fp8_f32(y0[4 * (j) + 2], y0[4 * (j) + 3], w0, true); \
    w1 = __builtin_amdgcn_cvt_pk_fp8_f32(y1[4 * (j)], y1[4 * (j) + 1], w1, false); w1 = __builtin_amdgcn_cvt_pk_fp8_f32(y1[4 * (j) + 2], y1[4 * (j) + 3], w1, true); \
    pa[j] = w0; pa[4 + (j)] = w1; } while (0)
#define LDFRAG(dst, base, o0, o1) do { const u32x4 _a = *reinterpret_cast<const u32x4*>((base) + (o0)), _b = *reinterpret_cast<const u32x4*>((base) + (o1)); \
    dst = i32x8{(int)_a.x, (int)_a.y, (int)_a.z, (int)_a.w, (int)_b.x, (int)_b.y, (int)_b.z, (int)_b.w}; } while (0)
__device__ __forceinline__ float vmax3(float a, float b, float c) { float r; asm("v_max3_f32 %0, %1, %2, %3" : "=v"(r) : "v"(a), "v"(b), "v"(c)); return r; }
__device__ __forceinline__ float vmax2(float a, float b) { float r; asm("v_max_f32 %0, %1, %2" : "=v"(r) : "v"(a), "v"(b)); return r; }
__device__ __forceinline__ float vmax8(float a0, float a1, float a2, float a3, float a4, float a5, float a6, float a7) { float r;
  asm("v_max3_f32 %0, %1, %2, %3\n\tv_max3_f32 %0, %0, %4, %5\n\tv_max3_f32 %0, %0, %6, %7\n\tv_max_f32 %0, %0, %8" : "=&v"(r) : "v"(a0), "v"(a1), "v"(a2), "v"(a3), "v"(a4), "v"(a5), "v"(a6), "v"(a7)); return r; }
__device__ __forceinline__ float vmax11(float a0, float a1, float a2, float a3, float a4, float a5, float a6, float a7, float b0, float b1, float b2) { float r;
  asm("v_max3_f32 %0, %1, %2, %3\n\tv_max3_f32 %0, %0, %4, %5\n\tv_max3_f32 %0, %0, %6, %7\n\tv_max3_f32 %0, %0, %8, %9\n\tv_max3_f32 %0, %0, %10, %11"
      : "=&v"(r) : "v"(a0), "v"(a1), "v"(a2), "v"(a3), "v"(a4), "v"(a5), "v"(a6), "v"(a7), "v"(b0), "v"(b1), "v"(b2)); return r; }
__device__ __forceinline__ float vmax9(float m, float a0, float a1, float a2, float a3, float a4, float a5, float a6, float a7) { float r;
  asm("v_max3_f32 %0, %1, %2, %3\n\tv_max3_f32 %0, %0, %4, %5\n\tv_max3_f32 %0, %0, %6, %7\n\tv_max3_f32 %0, %0, %8, %9" : "=&v"(r) : "v"(m), "v"(a0), "v"(a1), "v"(a2), "v"(a3), "v"(a4), "v"(a5), "v"(a6), "v"(a7)); return r; }
#define MAX8(v, b) vmax8(v[b], v[b + 1], v[b + 2], v[b + 3], v[b + 4], v[b + 5], v[b + 6], v[b + 7])
template <int KOFF, int VOFF, int NKOFF, bool HAVE, bool PRE> __device__ __forceinline__ float tile_step(i32x8& ka, i32x8& kb, f32x16& x0, f32x16& x1, f32x16& y0, f32x16& y1, i32x8& pa, f32x16* o, f32x4& lsum, const i32x8& ones8,
                                                                        const char* ldsb, const int (&ko)[4], const int (&vo)[2], const i32x8 (&q8)[2], const f32x16& cinit,
                                                                        bool dma, const unsigned char* vgl, size_t voff, unsigned vlo, const unsigned char* kgl, long koff, unsigned klo, LAS unsigned char* dst, bool& quiet) {
  i32x8 vf, vg;
  if (!HAVE) { LDFRAG(ka, ldsb + KOFF, ko[0], ko[1]); LDFRAG(kb, ldsb + KOFF + 4096, ko[0], ko[1]); }
  EXPQ(1); SBAR();
  x0 = __builtin_amdgcn_mfma_scale_f32_32x32x64_f8f6f4(ka, q8[0], cinit, 0, 0, 0, 0, 0, 0); SBAR();
  EXPQ(2); SBAR();
  x1 = __builtin_amdgcn_mfma_scale_f32_32x32x64_f8f6f4(kb, q8[0], cinit, 0, 0, 0, 0, 0, 0); SBAR();
  LDFRAG(ka, ldsb + KOFF, ko[2], ko[3]); LDFRAG(kb, ldsb + KOFF + 4096, ko[2], ko[3]);
  EXPQ(3); SBAR();
  x0 = __builtin_amdgcn_mfma_scale_f32_32x32x64_f8f6f4(ka, q8[1], x0, 0, 0, 0, 0, 0, 0); SBAR();
  PACKQ(0); PACKQ(1); PACKQ(2); PACKQ(3); SBAR();
  x1 = __builtin_amdgcn_mfma_scale_f32_32x32x64_f8f6f4(kb, q8[1], x1, 0, 0, 0, 0, 0, 0); SBAR();
  LDFRAG(vf, ldsb + VOFF, vo[0], vo[1]);
  SBAR();
  lsum = __builtin_amdgcn_mfma_scale_f32_16x16x128_f8f6f4(ones8, pa, lsum, 0, 0, 0, 0, 0, 0); SBAR();
  LDFRAG(vg, ldsb + VOFF + 2048, vo[0], vo[1]);
  if (dma) { __builtin_amdgcn_global_load_lds((const unsigned*)(vgl + voff + (size_t)vlo), (LAS unsigned*)dst, 16, 0, 0);
             __builtin_amdgcn_global_load_lds((const unsigned*)(kgl + koff + (size_t)klo), (LAS unsigned*)(dst + 65536), 16, 0, 0); }
  float m0 = MAX8(x0, 0); SBAR();
  o[0] = __builtin_amdgcn_mfma_scale_f32_32x32x64_f8f6f4(vf, pa, o[0], 0, 0, 0, 0, 0, 0); SBAR();
  LDFRAG(vf, ldsb + VOFF + 4096, vo[0], vo[1]);
  float m2 = MAX8(x1, 0);
#pragma unroll
  for (int r = 0; r < 4; ++r) x0[r] = __builtin_amdgcn_exp2f(x0[r]);
  SBAR();
  o[1] = __builtin_amdgcn_mfma_scale_f32_32x32x64_f8f6f4(vg, pa, o[1], 0, 0, 0, 0, 0, 0); SBAR();
  LDFRAG(vg, ldsb + VOFF + 6144, vo[0], vo[1]);
  const float mA = vmax9(m0, x0[8], x0[9], x0[10], x0[11], x0[12], x0[13], x0[14], x0[15]);
#pragma unroll
  for (int r = 0; r < 4; ++r) x1[r] = __builtin_amdgcn_exp2f(x1[r]);
  SBAR();
  o[2] = __builtin_amdgcn_mfma_scale_f32_32x32x64_f8f6f4(vf, pa, o[2], 0, 0, 0, 0, 0, 0); SBAR();
  if (PRE) { LDFRAG(ka, ldsb + NKOFF, ko[0], ko[1]); LDFRAG(kb, ldsb + NKOFF + 4096, ko[0], ko[1]); }
  const float mB = vmax9(m2, x1[8], x1[9], x1[10], x1[11], x1[12], x1[13], x1[14], x1[15]);
  float m3;
  { auto rr = __builtin_amdgcn_permlane32_swap(__float_as_uint(mA), __float_as_uint(mB), false, false);
    m3 = vmax2(__uint_as_float(rr[0]), __uint_as_float(rr[1])); }
  quiet = __all(m3 <= POFF8 + THR8); SBAR();
  o[3] = __builtin_amdgcn_mfma_scale_f32_32x32x64_f8f6f4(vg, pa, o[3], 0, 0, 0, 0, 0, 0); SBAR();
  return m3;
}
__device__ __forceinline__ void decideSM8(float pmax, bool quiet, f32x16& p0, f32x16& p1, f32x16& cinit, float& alpha) {
  if (__builtin_expect(quiet, 1)) alpha = 1.f;
  else { { auto rr = __builtin_amdgcn_permlane32_swap(__float_as_uint(pmax), __float_as_uint(pmax), false, false);
      pmax = fmaxf(__uint_as_float(rr[0]), __uint_as_float(rr[1])); }
    const float d = fmaxf(pmax - POFF8, 0.f);
    alpha = __builtin_amdgcn_exp2f(-d); asm volatile("s_nop 0" : "+v"(alpha));
    for (int r = 0; r < 4; ++r) { p0[r] *= alpha; p1[r] *= alpha; }
    for (int r = 4; r < 16; ++r) { p0[r] -= d; p1[r] -= d; }
    for (int r = 0; r < 16; ++r) cinit[r] -= d; }
}
__device__ __forceinline__ void q_to_fp8(const bf16x8 (&qr)[8], i32x8 (&q8)[2]) {
#pragma unroll
  for (int d0 = 0; d0 < 8; ++d0) { const u32x4 w = *reinterpret_cast<const u32x4*>(&qr[d0]);
    int lo = 0, hi2 = 0;
    lo = __builtin_amdgcn_cvt_pk_fp8_f32(sat8(bf_lo(w.x)), sat8(bf_hi(w.x)), lo, false); lo = __builtin_amdgcn_cvt_pk_fp8_f32(sat8(bf_lo(w.y)), sat8(bf_hi(w.y)), lo, true);
    hi2 = __builtin_amdgcn_cvt_pk_fp8_f32(sat8(bf_lo(w.z)), sat8(bf_hi(w.z)), hi2, false); hi2 = __builtin_amdgcn_cvt_pk_fp8_f32(sat8(bf_lo(w.w)), sat8(bf_hi(w.w)), hi2, true);
    q8[d0 >> 2][(d0 & 3) * 2] = lo; q8[d0 >> 2][(d0 & 3) * 2 + 1] = hi2; }
}
__device__ __forceinline__ void q_norm_rope(bf16x8 (&qr)[8], const float* __restrict__ gq, float qsc, int t, int hi) {
  float ss = 0.f;
#pragma unroll
  for (int d0 = 0; d0 < 8; ++d0) { const u32x4 w = *reinterpret_cast<const u32x4*>(&qr[d0]);
    ss += (bf_lo(w.x) * bf_lo(w.x) + bf_hi(w.x) * bf_hi(w.x)) + (bf_lo(w.y) * bf_lo(w.y) + bf_hi(w.y) * bf_hi(w.y)) + (bf_lo(w.z) * bf_lo(w.z) + bf_hi(w.z) * bf_hi(w.z)) + (bf_lo(w.w) * bf_lo(w.w) + bf_hi(w.w) * bf_hi(w.w)); }
  { auto rr = __builtin_amdgcn_permlane32_swap(__float_as_uint(ss), __float_as_uint(ss), false, false); ss = __uint_as_float(rr[0]) + __uint_as_float(rr[1]); }
  const float rs = qsc / sqrtf(ss * (1.0f / 128.0f) + 1e-6f);
#pragma unroll
  for (int d0 = 0; d0 < 8; ++d0) {
    const float pos = (float)((d0 < 4) ? (t >> 6) : (t & 63));
    const u32x4 w = *reinterpret_cast<const u32x4*>(&qr[d0]); const unsigned wi[4] = {w.x, w.y, w.z, w.w}; unsigned wo[4];
    const f32x4 ga = *(const f32x4*)(gq + d0 * 16 + hi * 8), gb = *(const f32x4*)(gq + d0 * 16 + hi * 8 + 4); const float g[8] = {ga[0], ga[1], ga[2], ga[3], gb[0], gb[1], gb[2], gb[3]};
#pragma unroll
    for (int jj = 0; jj < 4; ++jj) {
      const float inv = __builtin_amdgcn_exp2f(-(float)(8 * (d0 & 3) + 4 * hi + jj) * (13.287712379549449f / 32.0f)) * 0.15915494309189535f;
      const float rev = pos * inv, fr_ = rev - floorf(rev), cs = __builtin_amdgcn_cosf(fr_), sn = __builtin_amdgcn_sinf(fr_);
      const float y1 = bf_lo(wi[jj]) * rs * g[2 * jj], y2 = bf_hi(wi[jj]) * rs * g[2 * jj + 1];
      wo[jj] = cvt_pk_bf16(y1 * cs - y2 * sn, y1 * sn + y2 * cs);
    }
    const u32x4 o = {wo[0], wo[1], wo[2], wo[3]}; qr[d0] = *reinterpret_cast<const bf16x8*>(&o);
    __builtin_amdgcn_sched_barrier(0);
  }
}
__device__ __forceinline__ void attn_dense_body8(const bf16_t* __restrict__ Qb, const unsigned char* __restrict__ Kh, const unsigned char* __restrict__ Vt,
                                                bf16_t* __restrict__ Ob, int seq, char* lds, LAS unsigned char* ldsl, const float* __restrict__ gq, float qsc, int t0) {
  const int tid = threadIdx.x, wid = __builtin_amdgcn_readfirstlane(tid >> 6), lane = tid & 63, r32 = lane & 31, hi = lane >> 5;
  char* V_lds = lds; char* K_lds = lds + 65536;

  f32x16 o[4] = {}; f32x16 cinit = {}; f32x4 lsum = {}; bf16x8 qr[8];
  const int onesw = ((((lane >> 4) & 1) == 0) == ((lane & 15) < 8)) ? 0x38383838 : 0;
  i32x8 ones8 = {onesw, onesw, onesw, onesw, onesw, onesw, onesw, onesw}; asm volatile("" : "+v"(ones8));
  const bf16_t* Qw = Qb + (long)(wid * QBLK + r32) * LDQ + hi * 8;
#pragma unroll
  for (int d0 = 0; d0 < 8; ++d0) qr[d0] = __builtin_nontemporal_load(reinterpret_cast<const bf16x8*>(Qw + d0 * 16));
  { int tq = t0 + wid * QBLK + r32; asm volatile("" : "+v"(tq) :: "memory");
    int hq = hi; asm volatile("" : "+v"(hq));
    __builtin_amdgcn_sched_barrier(0); q_norm_rope(qr, gq, qsc, tq, hq); __builtin_amdgcn_sched_barrier(0); }
  i32x8 q8[2]; q_to_fp8(qr, q8);
  int tk = tid; asm volatile("" : "+v"(tk));
  const unsigned klo = (unsigned)((tk >> 3) * LDK + (((tk & 7) ^ ((tk >> 4) & 7)) << 4)); const unsigned char* kgl = Kh;
  const unsigned vlo = (unsigned)((tk >> 2) * 64 + (((tk & 3) ^ ((tk >> 4) & 3)) << 4)); const unsigned char* vgl = Vt;
#define DMA(t) do { LAS unsigned char* _st = ldsl + ((t) & 7) * 8192 + wid * 1024; \
    __builtin_amdgcn_global_load_lds((const unsigned*)(vgl + (size_t)(t) * 16384 + (size_t)vlo), (LAS unsigned*)_st, 16, 0, 0); \
    __builtin_amdgcn_global_load_lds((const unsigned*)(kgl + (long)(t) * (KVBLK * LDK) + (size_t)klo), (LAS unsigned*)(_st + 65536), 16, 0, 0); } while (0)
#define TILE_BAR(more) do { if (more) asm volatile("s_waitcnt vmcnt(4)" ::: "memory"); else asm volatile("s_waitcnt vmcnt(0)" ::: "memory"); asm volatile("s_waitcnt lgkmcnt(0)" ::: "memory"); __builtin_amdgcn_s_barrier(); asm volatile("" ::: "memory"); } while (0)
#define RESC1(a) do { { const float _a2 = __shfl((a), (lane & 15) + 16 * (lane >> 5)); for (int r = 0; r < 4; ++r) lsum[r] *= _a2; }     \
    for (int r = 0; r < 16; ++r) { for (int d = 0; d < 4; ++d) o[d][r] *= (a); } } while (0)
#define HALFS(t, STG, X0, X1, alX, Y0, Y1, alY, BAR) do { \
    SBAR(); \
    { bool _q; const float _pm = tile_step<(STG) * 8192, (((STG) + 7) & 7) * 8192, (((STG) + 1) & 7) * 8192, (BAR), !(BAR)>(ka, kb, X0, X1, Y0, Y1, pa, o, lsum, ones8, lds, ko, vo, q8, cinit, \
          (t) + 4 < NT, vgl, (size_t)((t) + 4) * 16384, vlo, kgl, (long)((t) + 4) * (KVBLK * LDK), klo, ldsl + (((t) + 4) & 7) * 8192 + wid * 1024, _q); \
      if (__builtin_expect(!_q, 0)) { decideSM8(_pm, false, X0, X1, cinit, alX); RESC1(alX); } } \
    if (BAR) TILE_BAR((t) + 4 < NT); } while (0)
  f32x16 pA0, pA1, pB0, pB1; float alA, alB; i32x8 pa = {}; i32x8 ka, kb; const int NT = seq / KVBLK;
  int ko[4], vo[2];
#pragma unroll
  for (int c = 0; c < 2; ++c)
#pragma unroll
    for (int h = 0; h < 2; ++h) ko[2 * c + h] = 65536 + KSWZ8(r32, 64 * c + 32 * hi + 16 * h);
  vo[0] = VSWZ8(r32, 2 * hi); vo[1] = VSWZ8(r32, 2 * hi + 1);
  DMA(0); DMA(1); DMA(2); DMA(3);
  TILE_BAR(true);
  DMA(4); SBAR();
  qkt8o<0>(pA0, pA1, lds, ko, q8, cinit); partialSM8(pA0, pA1, cinit, alA, true);
#pragma unroll
  for (int r = 0; r < 4; ++r) { pA0[r] = __builtin_amdgcn_exp2f(pA0[r]); pA1[r] = __builtin_amdgcn_exp2f(pA1[r]); }
  TILE_BAR(true);
#define OCT(tb, LAST7) do { \
    HALFS((tb) + 0, 1, pB0, pB1, alB, pA0, pA1, alA, false); \
    HALFS((tb) + 1, 2, pA0, pA1, alA, pB0, pB1, alB, true); \
    HALFS((tb) + 2, 3, pB0, pB1, alB, pA0, pA1, alA, false); \
    HALFS((tb) + 3, 4, pA0, pA1, alA, pB0, pB1, alB, true); \
    HALFS((tb) + 4, 5, pB0, pB1, alB, pA0, pA1, alA, false); \
    HALFS((tb) + 5, 6, pA0, pA1, alA, pB0, pB1, alB, true); \
    HALFS((tb) + 6, 7, pB0, pB1, alB, pA0, pA1, alA, false); \
    if (!(LAST7)) HALFS((tb) + 7, 0, pA0, pA1, alA, pB0, pB1, alB, true); } while (0)
  int tb = 1;
  for (; tb + 8 < NT; tb += 8) OCT(tb, false);
  OCT(tb, true);
  finishSM8<4>(pB0, pB1, pa); SBAR();
  lsum = __builtin_amdgcn_mfma_scale_f32_16x16x128_f8f6f4(ones8, pa, lsum, 0, 0, 0, 0, 0, 0);
#pragma unroll
  for (int d0 = 0; d0 < 4; ++d0) { i32x8 vf; LDFRAG(vf, lds + 7 * 8192 + d0 * 2048, vo[0], vo[1]);
    o[d0] = __builtin_amdgcn_mfma_scale_f32_32x32x64_f8f6f4(vf, pa, o[d0], 0, 0, 0, 0, 0, 0); }
  const float lown = __shfl(lsum[0], (lane & 15) + 32 * ((lane >> 4) & 1));
  float rl = __builtin_amdgcn_rcpf(lown); asm volatile("s_nop 0" : "+v"(rl));
  int hi_e = hi, r32_e = r32; asm volatile("" : "+v"(hi_e), "+v"(r32_e));
  char* Ow = (char*)(Ob + (long)(wid * QBLK + r32_e) * LDO) + hi_e * 16;
#pragma unroll
  for (int d0 = 0; d0 < 4; ++d0)
#pragma unroll
    for (int gp = 0; gp < 2; ++gp) {
      const int i0 = 8 * gp;
      unsigned ax = cvt_pk_bf16(o[d0][i0 + 0] * rl, o[d0][i0 + 1] * rl), ay = cvt_pk_bf16(o[d0][i0 + 2] * rl, o[d0][i0 + 3] * rl);
      unsigned bx = cvt_pk_bf16(o[d0][i0 + 4] * rl, o[d0][i0 + 5] * rl), by = cvt_pk_bf16(o[d0][i0 + 6] * rl, o[d0][i0 + 7] * rl);
      { auto r = __builtin_amdgcn_permlane32_swap(ax, bx, false, false); ax = r[0]; bx = r[1]; }
      { auto r = __builtin_amdgcn_permlane32_swap(ay, by, false, false); ay = r[0]; by = r[1]; }
      u32x4 w = {ax, ay, bx, by};
      *(u32x4*)(Ow + (d0 * 4 + gp * 2) * 16) = w; }
  __syncthreads();
#undef DMA
#undef TILE_BAR
#undef RESC1
#undef HALFS
#undef OCT
}
}

struct Frame {
    LAS unsigned char* lds; char* ldsg;
    int tid, lane, wave, vcu, G;
    unsigned char* ws;
};
struct Args { const float* in[18]; float* out; unsigned char* ws; int ph_lo, ph_hi; };

__device__ __forceinline__ void p0_transpose_item(const float* W, int N, int ncols, bf16_t* WT, int ldt, int col_off, const float* kscale, LAS float* scr, int item, int lane) {
    const int nblk = ncols / 32, kb = item / nblk, nb = item % nblk, k0 = 64 * kb, n0 = 32 * nb;
#pragma unroll 8
    for (int i = 0; i < 32; ++i) { const int kk = 2 * i + (lane >> 5); float w = __builtin_nontemporal_load(&W[(size_t)(k0 + kk) * N + n0 + (lane & 31)]); if (kscale) w *= kscale[k0 + kk]; scr[kk * 33 + (lane & 31)] = w; }
    asm volatile("s_waitcnt lgkmcnt(0)" ::: "memory");
    const int c = lane & 7;
#pragma unroll
    for (int j = 0; j < 4; ++j) { const int n = (lane >> 3) + 8 * j; const LAS float* s = scr + (8 * c) * 33 + n;
        u32x4 o; o.x = cvt_pk_bf16(s[0 * 33], s[1 * 33]); o.y = cvt_pk_bf16(s[2 * 33], s[3 * 33]); o.z = cvt_pk_bf16(s[4 * 33], s[5 * 33]); o.w = cvt_pk_bf16(s[6 * 33], s[7 * 33]);
        *(u32x4*)(WT + (size_t)(n0 + n) * ldt + col_off + k0 + 8 * c) = o; }
    asm volatile("s_waitcnt lgkmcnt(0)" ::: "memory");
}
__device__ __forceinline__ void p0_quant_w_in(const float* w_in, const float* norm_mix, unsigned char* w8, float* sw, LAS unsigned char* lds, int tid, int grp) {
    LAS float* red = (LAS float*)lds;
    LAS unsigned char* tile = lds + 4096;
    const int nn = tid & 31, kk = tid >> 5, n = grp * 30 + (nn < 30 ? nn : 29);
    float mx = 0.f;
    for (int j0 = 0; j0 < 128; j0 += 16) {
        float v[16];
#pragma unroll
        for (int j = 0; j < 16; ++j) { const int k = kk + 16 * (j0 + j); v[j] = w_in[(size_t)k * NIN + n] * norm_mix[k]; }
#pragma unroll
        for (int j = 0; j < 16; ++j) mx = fmaxf(mx, fabsf(v[j]));
    }
    red[kk * 32 + nn] = mx;
    __syncthreads();
    mx = 0.f;
#pragma unroll
    for (int i = 0; i < 16; ++i) mx = fmaxf(mx, red[i * 32 + nn]);
    const float inv = mx > 0.f ? 440.0f / mx : 1.0f;
    if (kk == 0 && nn < 30) sw[grp * 30 + nn] = mx > 0.f ? mx * (1.0f / 440.0f) : 1.0f;
    for (int j0 = 0; j0 < 128; j0 += 16) {
        float v[16];
#pragma unroll
        for (int j = 0; j < 16; ++j) { const int k = kk + 16 * (j0 + j); v[j] = w_in[(size_t)k * NIN + n] * norm_mix[k]; }
        if (nn < 30) {
#pragma unroll
            for (int j = 0; j < 16; j += 2) { int pk = 0; pk = __builtin_amdgcn_cvt_pk_fp8_f32(v[j] * inv, v[j + 1] * inv, pk, false);
                tile[nn * 2064 + kk + 16 * (j0 + j)] = (unsigned char)(pk & 0xff); tile[nn * 2064 + kk + 16 * (j0 + j + 1)] = (unsigned char)((pk >> 8) & 0xff); }
        }
    }
    __syncthreads();
    for (int ch = tid; ch < 30 * 128; ch += 512) { const int r = ch >> 7, cc = (ch & 127) * 16;
        *(u32x4*)(w8 + (size_t)(grp * 30 + r) * DM + cc) = *(const LAS u32x4*)(tile + r * 2064 + cc); }
    __syncthreads();
}
__device__ __forceinline__ void cvt_flat(const float* src, bf16_t* dst, size_t n8, const float* colscale, size_t gtid, size_t gthreads) {
    for (size_t i = gtid; i < n8; i += gthreads) {
        f32x4 a = *(const f32x4*)(src + i * 8), b = *(const f32x4*)(src + i * 8 + 4);
        if (colscale) { const int c = (int)((i * 8) & (DM - 1)); a = a * *(const f32x4*)(colscale + c); b = b * *(const f32x4*)(colscale + c + 4); }
        u32x4 w; w.x = cvt_pk_bf16(a[0], a[1]); w.y = cvt_pk_bf16(a[2], a[3]); w.z = cvt_pk_bf16(b[0], b[1]); w.w = cvt_pk_bf16(b[2], b[3]);
        *(u32x4*)(dst + i * 8) = w;
    }
}

__device__ __forceinline__ void quant_rows_fp8(const float* src, unsigned char* dst, float* scales, const float* colscale, int gw, int ngw, int lane, int row_lo, int row_hi) {
    for (int row = row_lo + gw; row < row_hi; row += ngw) {
        const f32x4* xr = (const f32x4*)(src + (size_t)row * DM) + lane; f32x4 v[8]; float mx = 0.f;
#pragma unroll
        for (int j = 0; j < 8; ++j) { v[j] = __builtin_nontemporal_load(xr + 64 * j); if (colscale) v[j] = v[j] * *((const f32x4*)colscale + lane + 64 * j);
            mx = fmaxf(mx, fmaxf(fmaxf(fabsf(v[j].x), fabsf(v[j].y)), fmaxf(fabsf(v[j].z), fabsf(v[j].w)))); }
#pragma unroll
        for (int o = 1; o < 64; o <<= 1) mx = fmaxf(mx, __shfl_xor(mx, o));
        const float sc = mx > 0.f ? mx * (1.0f / 440.0f) : 1.0f, inv = mx > 0.f ? 440.0f / mx : 1.0f;
        if (lane == 0) scales[row] = sc;
#pragma unroll
        for (int j = 0; j < 8; ++j) { int pk = 0; pk = __builtin_amdgcn_cvt_pk_fp8_f32(v[j].x * inv, v[j].y * inv, pk, false); pk = __builtin_amdgcn_cvt_pk_fp8_f32(v[j].z * inv, v[j].w * inv, pk, true);
            const int col = 4 * lane + 256 * j;
            *(int*)(dst + ((size_t)(col >> 7) * 16384 + row) * 128 + (col & 127)) = pk; }
    }
}

__device__ __forceinline__ int f2key(float f, unsigned payload, unsigned mask) { unsigned b = (__float_as_uint(f) & ~mask) | payload; return (int)(b ^ ((unsigned)((int)b >> 31) & 0x7fffffffu)); }
__device__ __forceinline__ unsigned key2bits(int k) { const unsigned b = (unsigned)k; return b ^ ((unsigned)(k >> 31) & 0x7fffffffu); }
template <int N> __device__ __forceinline__ void bitonic_sort_desc(int (&v)[N]) {
#pragma unroll
    for (int k = 2; k <= N; k <<= 1)
#pragma unroll
        for (int j = k >> 1; j > 0; j >>= 1)
#pragma unroll
            for (int i = 0; i < N; ++i) { const int l = i ^ j; if (l > i) { const int a = v[i], b = v[l]; const int mx = a > b ? a : b, mn = a > b ? b : a; if ((i & k) == 0) { v[i] = mx; v[l] = mn; } else { v[i] = mn; v[l] = mx; } } }
}
template <int N> __device__ __forceinline__ void bitonic_merge_desc(int (&v)[N]) {
#pragma unroll
    for (int j = N >> 1; j > 0; j >>= 1)
#pragma unroll
        for (int i = 0; i < N; ++i) { const int l = i ^ j; if (l > i) { const int a = v[i], b = v[l]; v[i] = a > b ? a : b; v[l] = a > b ? b : a; } }
}
__device__ __forceinline__ void top16_merge(int (&a)[16], const int (&b)[16]) {
#pragma unroll
    for (int i = 0; i < 16; ++i) a[i] = a[i] > b[15 - i] ? a[i] : b[15 - i];
    bitonic_merge_desc<16>(a);
}
__device__ __forceinline__ void top16_of_128(const f32x16 (&p)[4], int hi, int (&res)[16]) {
    int g[4][16];
#pragma unroll
    for (int mt = 0; mt < 4; ++mt) {
#pragma unroll
        for (int r = 0; r < 16; ++r) g[mt][r] = f2key(p[mt][r], (unsigned)(mt * 32 + att::crow(r, hi)), 127u);
        bitonic_sort_desc<16>(g[mt]);
    }
    top16_merge(g[0], g[1]); top16_merge(g[2], g[3]); top16_merge(g[0], g[2]);
    int o[16];
#pragma unroll
    for (int i = 0; i < 16; ++i) o[i] = __shfl_xor(g[0][i], 32);
    top16_merge(g[0], o);
#pragma unroll
    for (int i = 0; i < 16; ++i) res[i] = g[0][i];
}

#define CAND_LIST(X) X(0,0,0) X(1,0,1) X(2,0,2) X(3,0,3) X(4,0,4) X(5,0,5) X(6,0,6) X(7,0,7) X(8,0,8) X(9,0,9) X(10,0,10) X(11,0,11) X(12,0,12) X(13,0,13) X(14,0,14) X(15,0,15) \
    X(16,1,0) X(17,1,1) X(18,1,2) X(19,1,3) X(20,1,4) X(21,1,5) X(22,1,6) X(23,1,7) X(24,2,0) X(25,2,1) X(26,2,2) X(27,2,3) X(28,2,4) X(29,3,0) X(30,3,1) X(31,3,2) X(32,3,3) \
    X(33,4,0) X(34,4,1) X(35,4,2) X(36,5,0) X(37,5,1) X(38,6,0) X(39,6,1) X(40,7,0) X(41,7,1) X(42,8,0) X(43,9,0) X(44,10,0) X(45,11,0) X(46,12,0) X(47,13,0) X(48,14,0) X(49,15,0)

__global__ void __launch_bounds__(512, 2) fwd_kernel(Args args) {
    extern __shared__ __attribute__((aligned(16))) unsigned char lds_raw[];
    Frame F;
    F.lds = (LAS unsigned char*)lds_raw; F.ldsg = (char*)lds_raw;
    F.tid = threadIdx.x; F.lane = F.tid & 63; F.wave = __builtin_amdgcn_readfirstlane(F.tid >> 6);
    F.G = gridDim.x; { const int bx = blockIdx.x; F.vcu = (F.G % 8 == 0) ? (bx % 8) * (F.G / 8) + bx / 8 : bx; }
    F.ws = args.ws;
    unsigned char* ws = args.ws;
    const int lo = args.ph_lo, hi_ph = args.ph_hi;
    volatile LAS unsigned* MISC = (volatile LAS unsigned*)(F.lds + MISC_OFF);
    if (F.tid < 4) MISC[F.tid] = 0u;
    __syncthreads();
    XcdBarrier bar; bar.bar = (unsigned*)(ws + WS_CTL) + CW_BAR; bar.x = 0; bar.st = nullptr;
    if (MK_N_LAUNCHES == 1) bar = xcd_barrier_post((unsigned*)(ws + WS_CTL) + CW_BAR, MISC);
#define IN(k) (lo <= (k) && (k) < hi_ph)
#define PH_ON(k) ((PHASE_MASK >> (k)) & 1)
#define SEAM(k) do { if (IN(k) && IN((k) + 1)) xcd_barrier(bar); } while (0)
#define OPQ_TID() ({ int t_ = threadIdx.x; asm volatile("" : "+v"(t_)); t_; })
    const int gw = F.vcu * 8 + F.wave, NGW = F.G * 8;
    const size_t gtid = (size_t)blockIdx.x * 512 + F.tid, gthreads = (size_t)F.G * 512;

    const float* x = args.in[0]; const float* norm_mix = args.in[1]; const float* w_in = args.in[2]; const float* b_gate = args.in[3];
    const float* q_norm = args.in[4]; const float* k_norm = args.in[5]; const float* sgu_norm = args.in[6]; const float* w_sgu = args.in[7]; const float* b_sgu = args.in[8];
    const float* w_attn_proj = args.in[9]; const float* w_sgu_proj = args.in[10]; const float* w_out = args.in[11]; const float* norm_ffn = args.in[12];
    const float* w_peer_q = args.in[13]; const float* peer_k1 = args.in[14]; const float* peer_k2 = args.in[15]; const float* peer_u = args.in[16]; const float* peer_v = args.in[17];
    float* out = args.out;
    float* rsx = (float*)(ws + WS_RSX); float* swg = (float*)(ws + WS_SWG); unsigned char* x8 = ws + WS_X8; unsigned char* wg8 = ws + WS_WG8;
    float* ssqv = (float*)(ws + WS_SSQV); float* ssq2 = (float*)(ws + WS_SSQ2);
    bf16_t* k1b = (bf16_t*)(ws + WS_K1); bf16_t* k2b = (bf16_t*)(ws + WS_K2); bf16_t* wsgub = (bf16_t*)(ws + WS_WSGU);
    bf16_t* pcat = (bf16_t*)(ws + WS_PCAT); bf16_t* woutT = (bf16_t*)(ws + WS_WOUT); bf16_t* wpqT = (bf16_t*)(ws + WS_WPQ);
    bf16_t* merged = (bf16_t*)(ws + WS_B);
    int* eidx = (int*)(ws + WS_EIDX); float* gatev = (float*)(ws + WS_GATE); float* usu = (float*)(ws + WS_USU);
    unsigned char* vt8 = ws + WS_K + 4 * MiB;
    bf16_t* qb = (bf16_t*)(ws + WS_Q); bf16_t* kb = (bf16_t*)(ws + WS_K); bf16_t* vb = (bf16_t*)(ws + WS_V); bf16_t* gu = (bf16_t*)(ws + WS_GU); bf16_t* gv = (bf16_t*)(ws + WS_GV);
    bf16_t* h1b = (bf16_t*)(ws + WS_D);
    bf16_t* cat = (bf16_t*)(ws + WS_E); bf16_t* qp = (bf16_t*)(ws + WS_E);
    bf16_t* gates = (bf16_t*)(ws + WS_F); unsigned char* utab = ws + WS_UT; unsigned char* vtab = ws + WS_VT; float* su_sc = (float*)(ws + WS_SU); float* sv_sc = (float*)(ws + WS_SV);

    if (PH_ON(0) && IN(0)) {
        LAS float* scr = (LAS float*)(F.lds + F.wave * 16384);
        constexpr int I_PA = (1024 / 64) * (DM / 32), I_SQ = (DM / 64) * (DM / 32);
        constexpr int NITEMS = 2 * I_PA + 2 * I_SQ;
        for (int it = gw; it < NITEMS; it += NGW) {
            int r = it;
            if (r < I_PA) { p0_transpose_item(w_attn_proj, DM, DM, pcat, 2048, 0, nullptr, scr, r, F.lane); continue; } r -= I_PA;
            if (r < I_PA) { p0_transpose_item(w_sgu_proj, DM, DM, pcat, 2048, 1024, nullptr, scr, r, F.lane); continue; } r -= I_PA;
            if (r < I_SQ) { p0_transpose_item(w_out, DM, DM, woutT, DM, 0, nullptr, scr, r, F.lane); continue; } r -= I_SQ;
            p0_transpose_item(w_peer_q, DM, DM, wpqT, DM, 0, norm_ffn, scr, r, F.lane);
        }
        __syncthreads();
        for (int grp = (int)blockIdx.x; grp < NIN / 30; grp += F.G) p0_quant_w_in(w_in, norm_mix, wg8, swg, F.lds, F.tid, grp);
        cvt_flat(peer_k1, k1b, 131072 / 8, nullptr, gtid, gthreads);
        cvt_flat(peer_k2, k2b, 131072 / 8, nullptr, gtid, gthreads);
        cvt_flat(w_sgu, wsgub, 131072 / 8, nullptr, gtid, gthreads);
        for (int m = gw; m < SEQ; m += NGW) {
            const f32x4* xr = (const f32x4*)(x + (size_t)m * DM) + F.lane; f32x4 v[8]; float s = 0.f;
#pragma unroll
            for (int j = 0; j < 8; ++j) { v[j] = __builtin_nontemporal_load(xr + 64 * j); s += (v[j].x * v[j].x + v[j].y * v[j].y) + (v[j].z * v[j].z + v[j].w * v[j].w); }
            s = wave_sum(s);
            float mx = 0.f;
#pragma unroll
            for (int j = 0; j < 8; ++j) mx = fmaxf(mx, fmaxf(fmaxf(fabsf(v[j].x), fabsf(v[j].y)), fmaxf(fabsf(v[j].z), fabsf(v[j].w))));
#pragma unroll
            for (int o = 1; o < 64; o <<= 1) mx = fmaxf(mx, __shfl_xor(mx, o));
            const float rsd = 1.0f / sqrtf(s * (1.0f / DM) + EPS), inv8 = mx > 0.f ? 440.0f / mx : 1.0f;
            if (F.lane == 0) rsx[m] = rsd * (mx > 0.f ? mx * (1.0f / 440.0f) : 1.0f);
            int* o4 = (int*)(x8 + (size_t)m * DM) + F.lane;
#pragma unroll
            for (int j = 0; j < 8; ++j) { int pk = 0; pk = __builtin_amdgcn_cvt_pk_fp8_f32(v[j].x * inv8, v[j].y * inv8, pk, false); pk = __builtin_amdgcn_cvt_pk_fp8_f32(v[j].z * inv8, v[j].w * inv8, pk, true); o4[64 * j] = pk; }
        }
    }
    SEAM(0);

    if (PH_ON(1) && IN(1)) {
        pg8::Gemm g{(const bf16_t*)x8, (const bf16_t*)wg8, DM / 2, DM / 2, DM / 2}; pg8::P1Order S; S.init(SEQ / 256, NIN / 256, F.G, (int)blockIdx.x);
        pg8::Epi1 E{rsx, swg, qb, kb, vb, gu, gv, gates, b_gate, ssqv, k_norm, (LAS float*)(F.lds + RS2_OFF), SELFCHECK ? (bf16_t*)(ws + WS_DBGK) : nullptr, vt8};
        pg8::gemm_phase<pg8::Epi1, pg8::P1Order, true>(F.lds, g, S, E);
        if ((int)blockIdx.x >= 128) { const int l1 = OPQ_TID() & 63, w1 = ((int)blockIdx.x - 128) * 8 + F.wave;
            quant_rows_fp8(peer_u, utab, su_sc, norm_ffn, w1, 1024, l1, 0, QROWS_P1); quant_rows_fp8(peer_v, vtab, sv_sc, nullptr, w1, 1024, l1, 0, QROWS_P1); }
    }
    SEAM(1);


    if (PH_ON(3) && IN(3)) {
        for (int i = 0; i < 2; ++i) {
            const int L = i * 256 + F.vcu; if (L >= 512) break;
            const int h = L >> 6, qblk = L & 63, kvh = h >> 2;
            att::attn_dense_body8(qb + (size_t)(qblk * 256) * QW + h * HD, (const unsigned char*)kb + kvh * HD, vt8 + kvh * 8192, cat + (size_t)(qblk * 256) * 2048 + h * HD, SEQ, F.ldsg, F.lds, q_norm, att::SCALE * 1.4426950408889634f, qblk * 256);
        }
        int tidS = threadIdx.x; asm volatile("" : "+v"(tidS));
        const int laneS = tidS & 63;
        LAS bf16_t* vnT = (LAS bf16_t*)F.lds;
        LAS float* rsq = (LAS float*)(F.lds + 128 * 136 * 2);
        for (int s = F.vcu; s < 1024; s += 256) {
            const int c = s >> 3, g = s & 7;
            if (tidS < 128) { const f32x4* pp = (const f32x4*)(ssqv + (size_t)(c * 128 + tidS) * 16); const f32x4 a = pp[0], b = pp[1], cc = pp[2], d = pp[3];
                const float tot = ((a.x + a.y) + (a.z + a.w)) + ((b.x + b.y) + (b.z + b.w)) + ((cc.x + cc.y) + (cc.z + cc.w)) + ((d.x + d.y) + (d.z + d.w));
                rsq[tidS] = 1.0f / sqrtf(tot * (1.0f / SGW) + EPS); }
            __syncthreads();
#pragma unroll
            for (int pss = 0; pss < 4; ++pss) {
                const int ch = pss * 512 + tidS, qq = ch >> 4, d0 = (ch & 15) * 8;
                const u32x4 w = __builtin_nontemporal_load((const u32x4*)(gv + (size_t)(c * 128 + qq) * SGW + g * 128 + d0));
                const float rs = rsq[qq]; const f32x4 n0 = *(const f32x4*)(sgu_norm + g * 128 + d0), n1 = *(const f32x4*)(sgu_norm + g * 128 + d0 + 4);
                float e[8] = {bf_lo(w.x) * rs * n0.x, bf_hi(w.x) * rs * n0.y, bf_lo(w.y) * rs * n0.z, bf_hi(w.y) * rs * n0.w, bf_lo(w.z) * rs * n1.x, bf_hi(w.z) * rs * n1.y, bf_lo(w.w) * rs * n1.z, bf_hi(w.w) * rs * n1.w};
#pragma unroll
                for (int j = 0; j < 8; ++j) vnT[(d0 + j) * 136 + qq] = (bf16_t)(cvt_pk_bf16(e[j], e[j]) & 0xffffu);
            }
            __syncthreads();
            {
                const int fr = laneS & 15, fq = laneS >> 4, w = F.wave;
                bf16x8 af[4];
#pragma unroll
                for (int ks = 0; ks < 4; ++ks) af[ks] = *(const bf16x8*)(wsgub + (size_t)g * 16384 + (size_t)(16 * w + fr) * 128 + ks * 32 + fq * 8);
                f32x4 acc[8];
#pragma unroll
                for (int n = 0; n < 8; ++n) { acc[n] = (f32x4){0.f, 0.f, 0.f, 0.f};
#pragma unroll
                    for (int ks = 0; ks < 4; ++ks) { const bf16x8 bfrag = *(const LAS bf16x8*)(vnT + (16 * n + fr) * 136 + ks * 32 + fq * 8);
                        acc[n] = __builtin_amdgcn_mfma_f32_16x16x32_bf16(bfrag, af[ks], acc[n], 0, 0, 0); } }
                const int p = 16 * w + fr; const float bb = b_sgu[g * 128 + p];
                const size_t rowoff = (size_t)(c * 128 + p);
#pragma unroll
                for (int n = 0; n < 8; ++n) { const int d = 16 * n + 4 * fq;
                    const u32x2 uw = __builtin_nontemporal_load((const u32x2*)(gu + rowoff * SGW + g * 128 + d));
                    const float o0 = bf_lo(uw.x) * (acc[n][0] + bb), o1 = bf_hi(uw.x) * (acc[n][1] + bb), o2 = bf_lo(uw.y) * (acc[n][2] + bb), o3 = bf_hi(uw.y) * (acc[n][3] + bb);
                    u32x2 ow; ow.x = cvt_pk_bf16(o0, o1); ow.y = cvt_pk_bf16(o2, o3);
                    *(u32x2*)(cat + rowoff * 2048 + 1024 + g * 128 + d) = ow; }
            }
            __syncthreads();
        }
    }
    SEAM(3);

#if SELFCHECK
    if (IN(4) && gw < 64) {
        const int l = OPQ_TID() & 63; const int t = (int)((((unsigned)gw * 2654435761u) >> 9) & 16383u), h = gw & 7, kvh = h >> 2;
        LAS float* qs = (LAS float*)(F.lds) + F.wave * 128;
        float* sc = (float*)(ws + WS_DBGS) + (size_t)gw * 16384;
        const bf16_t* dq = qb; const bf16_t* dk = (const bf16_t*)(ws + WS_DBGK);
        {
            const float x1 = __uint_as_float((unsigned)dq[(size_t)t * 1024 + h * 128 + 2 * l] << 16), x2 = __uint_as_float((unsigned)dq[(size_t)t * 1024 + h * 128 + 2 * l + 1] << 16);
            const float rs = 1.0f / sqrtf(wave_sum(x1 * x1 + x2 * x2) / 128.0f + 1e-6f);
            const float y1 = x1 * rs * q_norm[2 * l], y2 = x2 * rs * q_norm[2 * l + 1];
            const float pos = (l < 32) ? (float)(t / 64) : (float)(t % 64); const float freq = expf(-(float)(l % 32) / 32.0f * logf(10000.0f));
            const float a = pos * freq, rev = a * 0.15915494309189535f, fr = rev - floorf(rev); const float cs = __builtin_amdgcn_cosf(fr), sn = __builtin_amdgcn_sinf(fr);
            qs[2 * l] = y1 * cs - y2 * sn; qs[2 * l + 1] = y1 * sn + y2 * cs;
        }
        float M = -1e30f, L = 0.f;
        for (int ch = 0; ch < 256; ++ch) {
            const int key = ch * 64 + l; const bf16_t* kr = dk + (size_t)key * 256 + kvh * 128;
            float ss = 0.f;
            for (int i = 0; i < 128; ++i) { const float x = __uint_as_float((unsigned)kr[i] << 16); ss += x * x; }
            const float rs = 1.0f / sqrtf(ss / 128.0f + 1e-6f); float dot = 0.f;
            for (int i = 0; i < 64; ++i) {
                const float y1 = __uint_as_float((unsigned)kr[2 * i] << 16) * rs * k_norm[2 * i], y2 = __uint_as_float((unsigned)kr[2 * i + 1] << 16) * rs * k_norm[2 * i + 1];
                const float pos = (i < 32) ? (float)(key / 64) : (float)(key % 64); const float freq = expf(-(float)(i % 32) / 32.0f * logf(10000.0f));
                const float a = pos * freq, rev = a * 0.15915494309189535f, fr = rev - floorf(rev); const float cs = __builtin_amdgcn_cosf(fr), sn = __builtin_amdgcn_sinf(fr);
                dot += qs[2 * i] * (y1 * cs - y2 * sn) + qs[2 * i + 1] * (y1 * sn + y2 * cs);
            }
            const float sv_ = dot * 0.08838834764831845f; sc[key] = sv_;
            const float Mn = fmaxf(M, sv_); L = L * expf(M - Mn) + expf(sv_ - Mn); M = Mn;
        }
        float Mw = M;
#pragma unroll
        for (int o = 1; o < 64; o <<= 1) Mw = fmaxf(Mw, __shfl_xor(Mw, o));
        const float Lw = wave_sum(L * expf(M - Mw));
        float o1 = 0.f, o2 = 0.f;
        for (int ch = 0; ch < 256; ++ch) {
            const float pk = expf(sc[ch * 64 + l] - Mw) / Lw;
            for (int kk = 0; kk < 64; ++kk) { const float pb = __uint_as_float(__builtin_amdgcn_readlane(__float_as_uint(pk), kk));
                const unsigned vw = *(const unsigned*)(vb + (size_t)(ch * 64 + kk) * 256 + kvh * 128 + 2 * l); o1 += pb * bf_lo(vw); o2 += pb * bf_hi(vw); }
        }
        const unsigned cw = *(const unsigned*)(cat + (size_t)t * 2048 + h * 128 + 2 * l);
        float err = fmaxf(fabsf(o1 - bf_lo(cw)), fabsf(o2 - bf_hi(cw))), ref = fmaxf(fabsf(o1), fabsf(o2));
#pragma unroll
        for (int o = 1; o < 64; o <<= 1) { err = fmaxf(err, __shfl_xor(err, o)); ref = fmaxf(ref, __shfl_xor(ref, o)); }
        if (!(err <= 0.05f * ref + 1e-5f) && l == 0) atomicAdd((unsigned*)(ws + WS_CTL) + CW_CHK, 1u);
    }
    if (IN(3) && IN(4)) xcd_barrier(bar);
#endif
    if (PH_ON(4) && IN(4)) {
        pg8::Gemm g{cat, pcat, 2048, 2048, 2048}; pg8::Order2D S; S.init(SEQ / 256, DM / 256, F.G, (int)blockIdx.x);
        pg8::Epi3 E{ws};
        pg8::gemm_phase<pg8::Epi3, pg8::Order2D>(F.lds, g, S, E);
    }
    SEAM(4);

    if (PH_ON(5) && IN(5)) {
        { const int l5 = OPQ_TID() & 63; quant_rows_fp8(peer_u, utab, su_sc, norm_ffn, gw, NGW, l5, QROWS_P1, 16384); quant_rows_fp8(peer_v, vtab, sv_sc, nullptr, gw, NGW, l5, QROWS_P1, 16384); }
        pg8::Gemm g{merged, woutT, DM, DM, DM}; pg8::Order2D S; S.init(SEQ / 256, DM / 256, F.G, (int)blockIdx.x);
        pg8::Epi4 E{x, out, h1b, ssq2};
        pg8::gemm_phase<pg8::Epi4, pg8::Order2D>(F.lds, g, S, E);
    }
    SEAM(5);

    if (PH_ON(6) && IN(6)) {
        pg8::Order2D S; S.init(SEQ / 256, DM / 256, F.G, (int)blockIdx.x);
        LAS float* rs2 = (LAS float*)(F.lds + RS2_OFF);
        {
            const int t6 = OPQ_TID(); const int ui = t6 >> 8, rl = t6 & 255; pg8::Unit u;
            if (S.next(ui, u)) { const f32x4* pp = (const f32x4*)(ssq2 + (size_t)(u.pm * 256 + rl) * 32); float tot = 0.f;
#pragma unroll
                for (int j = 0; j < 8; ++j) { const f32x4 a = pp[j]; tot += (a.x + a.y) + (a.z + a.w); }
                rs2[ui * 256 + rl] = 1.0f / sqrtf(tot * (1.0f / DM) + EPS); }
        }
        __syncthreads();
        pg8::Gemm g{h1b, wpqT, DM, DM, DM};
        pg8::Epi5 E{rs2, qp};
        pg8::gemm_phase<pg8::Epi5, pg8::Order2D>(F.lds, g, S, E);
        asm volatile("s_waitcnt vmcnt(0)" ::: "memory");
        __syncthreads();
        int tid6 = threadIdx.x; asm volatile("" : "+v"(tid6));
        const int r32 = tid6 & 31, hi = (tid6 >> 5) & 1;
        LAS unsigned* ixs = (LAS unsigned*)(F.lds) + (F.wave * 64 + (tid6 & 63)) * 9;
        for (int ui = 0; ui < 2; ++ui) {
            pg8::Unit u; if (!S.next(ui, u)) break;
            const int head = u.pn, tok = u.pm * 256 + F.wave * 32 + r32;
            const bf16_t* qrow = qp + (size_t)tok * DM + head * 256;
            int v1[16], v2[16];
#pragma unroll
            for (int half = 0; half < 2; ++half) {
                const bf16_t* kk = (half ? k2b : k1b) + (size_t)head * 16384;
                bf16x8 qf[8];
#pragma unroll
                for (int ks = 0; ks < 8; ++ks) qf[ks] = *(const bf16x8*)(qrow + half * 128 + ks * 16 + hi * 8);
                f32x16 p[4];
#pragma unroll
                for (int mt = 0; mt < 4; ++mt) { p[mt] = f32x16{};
#pragma unroll
                    for (int ks = 0; ks < 8; ++ks) { const bf16x8 kf = *(const bf16x8*)(kk + (size_t)(mt * 32 + r32) * 128 + ks * 16 + hi * 8);
                        p[mt] = __builtin_amdgcn_mfma_f32_32x32x16_bf16(kf, qf[ks], p[mt], 0, 0, 0); } }
                if (half == 0) top16_of_128(p, hi, v1); else top16_of_128(p, hi, v2);
            }
            float f1[16], f2[16];
            {
                unsigned pk[8];
#pragma unroll
                for (int i = 0; i < 8; ++i) pk[i] = 0u;
#pragma unroll
                for (int i = 0; i < 16; ++i) { const unsigned b1 = key2bits(v1[i]), b2 = key2bits(v2[i]);
                    f1[i] = __uint_as_float(b1 & ~127u); f2[i] = __uint_as_float(b2 & ~127u);
                    pk[i >> 2] |= (b1 & 127u) << (8 * (i & 3)); pk[4 + (i >> 2)] |= (b2 & 127u) << (8 * (i & 3)); }
#pragma unroll
                for (int i = 0; i < 8; ++i) ixs[i] = pk[i];
            }
            int cg[4][16];
#define X(k, i, j) cg[(k) >> 4][(k) & 15] = f2key(f1[i] + f2[j], (unsigned)((i) * 16 + (j)), 255u);
            CAND_LIST(X)
#undef X
#pragma unroll
            for (int k = 50; k < 64; ++k) cg[k >> 4][k & 15] = (int)0x80000000;
            bitonic_sort_desc<16>(cg[0]); bitonic_sort_desc<16>(cg[1]); bitonic_sort_desc<16>(cg[2]); bitonic_sort_desc<16>(cg[3]);
            top16_merge(cg[0], cg[1]); top16_merge(cg[2], cg[3]); top16_merge(cg[0], cg[2]);
            float cv[16]; unsigned cid[16];
#pragma unroll
            for (int i = 0; i < 16; ++i) { const unsigned b = key2bits(cg[0][i]); cv[i] = __uint_as_float(b & ~255u); cid[i] = b & 255u; }
            float sum = 0.f; float ex[16];
#pragma unroll
            for (int i = 0; i < 16; ++i) { ex[i] = __builtin_amdgcn_exp2f((cv[i] - cv[0]) * 1.4426950408889634f); sum += ex[i]; }
            const float rsum = 1.0f / sum;
            asm volatile("s_waitcnt lgkmcnt(0)" ::: "memory");
            if (hi == 0) {
                int eo[16]; float go[16];
#pragma unroll
                for (int i = 0; i < 16; ++i) { const unsigned ii = cid[i] >> 4, jj = cid[i] & 15u;
                    const unsigned e1 = (ixs[ii >> 2] >> (8 * (ii & 3))) & 127u, e2 = (ixs[4 + (jj >> 2)] >> (8 * (jj & 3))) & 127u;
                    eo[i] = (int)(e1 * 128u + e2); go[i] = ex[i] * rsum; }
                float uo[16];
#pragma unroll
                for (int i = 0; i < 16; ++i) { uo[i] = su_sc[eo[i]]; go[i] *= sv_sc[eo[i]]; }
                int* ep = eidx + (size_t)tok * 128 + head * 16; float* gp = gatev + (size_t)tok * 128 + head * 16; float* up = usu + (size_t)tok * 128 + head * 16;
#pragma unroll
                for (int i = 0; i < 4; ++i) { *(int4*)(ep + 4 * i) = make_int4(eo[4 * i], eo[4 * i + 1], eo[4 * i + 2], eo[4 * i + 3]); *(f32x4*)(gp + 4 * i) = (f32x4){go[4 * i], go[4 * i + 1], go[4 * i + 2], go[4 * i + 3]};
                    *(f32x4*)(up + 4 * i) = (f32x4){uo[4 * i], uo[4 * i + 1], uo[4 * i + 2], uo[4 * i + 3]}; }
            }
            asm volatile("s_waitcnt lgkmcnt(0)" ::: "memory");
        }
    }
    SEAM(6);

    if (PH_ON(7) && IN(7)) {
        int tid7 = threadIdx.x; asm volatile("" : "+v"(tid7));
        const int l = tid7 & 63, p = l >> 3, c = l & 7;
        LAS unsigned* eo = (LAS unsigned*)(F.lds) + F.wave * 3072;
        LAS float* av = (LAS float*)(F.lds) + F.wave * 3072 + 1024;
        LAS float* gs = (LAS float*)(F.lds) + F.wave * 3072 + 2048;
        const int grp = blockIdx.x & 7, ci = blockIdx.x >> 3;
        const unsigned c16 = (unsigned)c * 16u;
        const float poison = (SELFCHECK && __hip_atomic_load((unsigned*)(ws + WS_CTL) + CW_CHK, __ATOMIC_RELAXED, __HIP_MEMORY_SCOPE_AGENT) != 0u) ? __builtin_nanf("") : 0.f;
        typedef __bf16 b2v __attribute__((ext_vector_type(2)));
        {
            const int t0 = grp * 2048 + ci * 64 + F.wave * 8;
#pragma unroll
            for (int tt = 0; tt < 8; ++tt) {
#pragma unroll
                for (int hf = 0; hf < 2; ++hf) { const size_t gi = (size_t)(t0 + tt) * 128 + hf * 64 + l; const int li = tt * 128 + hf * 64 + l;
                    eo[li] = (unsigned)eidx[gi] << 7; av[li] = usu[gi]; gs[li] = gatev[gi]; } }
            float acc[8][16];
#pragma unroll
            for (int tt = 0; tt < 8; ++tt)
#pragma unroll
                for (int r = 0; r < 16; ++r) acc[tt][r] = 0.f;
            for (int sl = 0; sl < 16; ++sl) {
                asm volatile("" ::: "memory");
                const unsigned char* ub = utab + (size_t)sl * (2u << 20);
#pragma unroll
                for (int tt = 0; tt < 8; ++tt) {
                    const u32x4* xp = (const u32x4*)((const char*)h1b + (size_t)(t0 + tt) * 4096 + sl * 256 + c * 32);
                    const u32x4 xs0 = xp[0], xs1 = xp[1];
                    const unsigned xs[8] = {xs0.x, xs0.y, xs0.z, xs0.w, xs1.x, xs1.y, xs1.z, xs1.w};
                    u32x4 w[16];
#pragma unroll
                    for (int r = 0; r < 16; ++r) { const unsigned vo = eo[tt * 128 + r * 8 + p] | c16; w[r] = *(const u32x4*)(ub + vo); }
#pragma unroll
                    for (int r = 0; r < 16; ++r) { float a = acc[tt][r];
#pragma unroll
                        for (int j = 0; j < 4; ++j) { const unsigned dw = w[r][j];
                            a = __builtin_amdgcn_fdot2_f32_bf16(__builtin_amdgcn_cvt_scalef32_pk_bf16_fp8(dw, 1.0f, false), __builtin_bit_cast(b2v, xs[2 * j]), a, false);
                            a = __builtin_amdgcn_fdot2_f32_bf16(__builtin_amdgcn_cvt_scalef32_pk_bf16_fp8(dw, 1.0f, true), __builtin_bit_cast(b2v, xs[2 * j + 1]), a, false); }
                        acc[tt][r] = a; __builtin_amdgcn_sched_barrier(0); }
                    __builtin_amdgcn_sched_barrier(0);
                }
            }
#pragma unroll
            for (int tt = 0; tt < 8; ++tt) {
                float tot = (l < 32) ? ssq2[(size_t)(t0 + tt) * 32 + l] : 0.f; tot = wave_sum(tot);
                const float rs2v = 1.0f / sqrtf(tot * (1.0f / DM) + EPS);
#pragma unroll
                for (int r = 0; r < 16; ++r) { float a = acc[tt][r]; a += __shfl_xor(a, 1); a += __shfl_xor(a, 2); a += __shfl_xor(a, 4);
                    const int li = tt * 128 + r * 8 + p;
                    av[li] = gelu_tanh(a * rs2v * av[li]) * gs[li]; }
                __builtin_amdgcn_sched_barrier(0);
            }
            for (int sl = 0; sl < 16; ++sl) {
                asm volatile("" ::: "memory");
                const unsigned char* vbp = vtab + (size_t)sl * (2u << 20);
#pragma unroll
                for (int tt = 0; tt < 8; ++tt) {
                    u32x4 w[16];
#pragma unroll
                    for (int r = 0; r < 16; ++r) { const unsigned vo = eo[tt * 128 + r * 8 + p] | c16; w[r] = *(const u32x4*)(vbp + vo); }
                    float o16[16];
#pragma unroll
                    for (int i = 0; i < 16; ++i) o16[i] = 0.f;
#pragma unroll
                    for (int r = 0; r < 16; ++r) { const float a = av[tt * 128 + r * 8 + p];
#pragma unroll
                        for (int j = 0; j < 4; ++j) { const unsigned dw = w[r][j]; const f32x2 lo2 = __builtin_amdgcn_cvt_pk_f32_fp8(dw, false), hi2 = __builtin_amdgcn_cvt_pk_f32_fp8(dw, true);
                            o16[4 * j + 0] += a * lo2.x; o16[4 * j + 1] += a * lo2.y; o16[4 * j + 2] += a * hi2.x; o16[4 * j + 3] += a * hi2.y; }
                        __builtin_amdgcn_sched_barrier(0); }
                    const bool b0 = (p & 1) != 0, b1 = (p & 2) != 0, b2 = (p & 4) != 0;
                    float n8[8], n4[4], n2[2];
#pragma unroll
                    for (int i = 0; i < 8; ++i) { const float keep = b0 ? o16[8 + i] : o16[i], send = b0 ? o16[i] : o16[8 + i]; n8[i] = keep + __shfl_xor(send, 8); }
#pragma unroll
                    for (int i = 0; i < 4; ++i) { const float keep = b1 ? n8[4 + i] : n8[i], send = b1 ? n8[i] : n8[4 + i]; n4[i] = keep + __shfl_xor(send, 16); }
#pragma unroll
                    for (int i = 0; i < 2; ++i) { const float keep = b2 ? n4[2 + i] : n4[i], send = b2 ? n4[i] : n4[2 + i]; n2[i] = keep + __shfl_xor(send, 32); }
                    f32x2* op = (f32x2*)(out + (size_t)(t0 + tt) * DM + sl * 128 + c * 16 + ((p & 1) * 8 + ((p >> 1) & 1) * 4 + ((p >> 2) & 1) * 2));
                    const unsigned hw = *(const unsigned*)(h1b + (size_t)(t0 + tt) * DM + sl * 128 + c * 16 + ((p & 1) * 8 + ((p >> 1) & 1) * 4 + ((p >> 2) & 1) * 2));
                    f32x2 hv; hv.x = bf_lo(hw) + n2[0] + poison; hv.y = bf_hi(hw) + n2[1] + poison; __builtin_nontemporal_store(hv, op);
                    __builtin_amdgcn_sched_barrier(0);
                }
            }
        }
    }
#undef IN
#undef SEAM
}

extern "C" void kernel_launch(void* const* d_in, const int* in_sizes, int n_in, void* d_out, int out_size, void* d_ws, size_t ws_size, hipStream_t stream) {
    static int grid = 0;
    if (grid == 0) {
        if (n_in != 18 || in_sizes[0] != SEQ * DM || out_size != SEQ * DM || ws_size < WS_END) {
            fprintf(stderr, "kernel_launch: shape mismatch (n_in %d, in0 %d, out %d, ws %zu; need ws >= %zu)\n", n_in, n_in > 0 ? in_sizes[0] : -1, out_size, ws_size, (size_t)WS_END); grid = -1; return; }
        int dev = 0, cus = 0, per_cu = 0;
        if (hipGetDevice(&dev) != hipSuccess || hipDeviceGetAttribute(&cus, hipDeviceAttributeMultiprocessorCount, dev) != hipSuccess) { grid = -1; return; }
        if (hipFuncSetAttribute((const void*)fwd_kernel, hipFuncAttributeMaxDynamicSharedMemorySize, LDS_BYTES) != hipSuccess) { fprintf(stderr, "kernel_launch: hipFuncSetAttribute failed\n"); grid = -1; return; }
        if (hipOccupancyMaxActiveBlocksPerMultiprocessor(&per_cu, (const void*)fwd_kernel, 512, LDS_BYTES) != hipSuccess || per_cu < 1) { fprintf(stderr, "kernel_launch: occupancy query says %d blocks per CU\n", per_cu); grid = -1; return; }
        (void)hipGetLastError();
        grid = cus;
        if (grid != 256) { fprintf(stderr, "kernel_launch: expected 256 CUs, got %d\n", grid); grid = -1; return; }
    }
    if (grid < 0) return;
    (void)hipMemsetAsync((char*)d_ws + WS_CTL, 0, CTL_ZERO_BYTES, stream);
    Args a{};
    for (int i = 0; i < 18; ++i) a.in[i] = (const float*)d_in[i];
    a.out = (float*)d_out; a.ws = (unsigned char*)d_ws;
    if (PROBE_SPLIT >= 0) { a.ph_lo = 0; a.ph_hi = PROBE_SPLIT + 1; hipLaunchKernelGGL(fwd_kernel, dim3(grid), dim3(512), LDS_BYTES, stream, a);
        (void)hipMemsetAsync((char*)d_ws + WS_CTL, 0, CTL_ZERO_BYTES, stream);
        a.ph_lo = PROBE_SPLIT; a.ph_hi = NPH; hipLaunchKernelGGL(fwd_kernel, dim3(grid), dim3(512), LDS_BYTES, stream, a); }
    else if (MK_N_LAUNCHES == 1) { a.ph_lo = 0; a.ph_hi = NPH; hipLaunchKernelGGL(fwd_kernel, dim3(grid), dim3(512), LDS_BYTES, stream, a); }
    else { for (int p = 0; p < NPH; ++p) { a.ph_lo = p; a.ph_hi = p + 1; hipLaunchKernelGGL(fwd_kernel, dim3(grid), dim3(512), LDS_BYTES, stream, a); } }
    const hipError_t le = hipPeekAtLastError();
    if (le != hipSuccess) fprintf(stderr, "kernel_launch: launch failed: %s\n", hipGetErrorName(le));
}
```
